# Optimizing an MI355X kernel written in HIP

```python
import math
import jax, jax.numpy as jnp
from jax import lax
import numpy as np

D_MODEL = 1024
BATCH = 16
SEQ = 2048
DEPTH = 1

HG_HEADS = 4
HG_KDIM = 128
HG_VDIM = 128
HG_KWIDTH = HG_HEADS * HG_KDIM
HG_WIDTH = HG_HEADS * HG_VDIM
DA_HEADS = 4
DA_HEAD_DIM = 64
DA_WIDTH = DA_HEADS * 2 * DA_HEAD_DIM
MIX_WIDTH = HG_WIDTH + DA_WIDTH
IN_SIZES = (HG_KWIDTH, HG_KWIDTH, HG_WIDTH, HG_WIDTH, DA_WIDTH, DA_WIDTH, DA_WIDTH)
IN_WIDTH = sum(IN_SIZES)
D_FF = -(-8 * D_MODEL // (3 * 256)) * 256
CHUNK = 64
Q_BLOCK = 128
EPS = 1e-6
N_MOD = 6

kernel_name = "hymba_hgrn2_diffattn_alibi_adaln_block"


def rmsnorm(x, w):
    x32 = x.astype(jnp.float32)
    y = x32 * lax.rsqrt(jnp.mean(x32 * x32, axis=-1, keepdims=True) + EPS)
    return (y * w.astype(jnp.float32)).astype(x.dtype)


def alibi_slopes(n):
    return jnp.asarray(np.array([2.0 ** (-8.0 * (h + 1) / n) for h in range(n)], dtype=np.float32))


def hgrn2(q, f_logit, i, g, lb, gnorm_w):
    B, T, _ = q.shape
    n = T // CHUNK
    f = lb + (1.0 - lb) * jax.nn.sigmoid(f_logit.astype(jnp.float32))
    logf = jnp.log(f)
    k = 1.0 - f

    def heads(t, d):
        return t.reshape(B, n, CHUNK, HG_HEADS, d).transpose(1, 0, 3, 2, 4)

    qc = heads(q.astype(jnp.float32), HG_KDIM)
    kc = heads(k, HG_KDIM)
    vc = heads(i.astype(jnp.float32), HG_VDIM)
    bc = jnp.cumsum(heads(logf, HG_KDIM), axis=3)
    causal = jnp.tril(jnp.ones((CHUNK, CHUNK), dtype=bool))[:, :, None]

    def step(S, inp):
        qb, kb, vb, bb = inp
        o_inter = jnp.einsum('bhtk,bhkv->bhtv', qb * jnp.exp(bb), S)
        rel = bb[:, :, :, None, :] - bb[:, :, None, :, :]
        decay = jnp.exp(jnp.where(causal, rel, -jnp.inf))
        A = jnp.einsum('bhtk,bhsk,bhtsk->bhts', qb, kb, decay)
        o = o_inter + jnp.einsum('bhts,bhsv->bhtv', A, vb)
        blast = bb[:, :, -1:, :]
        S_new = jnp.exp(blast[:, :, 0, :])[..., None] * S + jnp.einsum('bhsk,bhsv->bhkv', kb * jnp.exp(blast - bb), vb)
        return S_new, o

    S0 = jnp.zeros((B, HG_HEADS, HG_KDIM, HG_VDIM), jnp.float32)
    _, o = lax.scan(step, S0, (qc, kc, vc, bc))
    o = o.transpose(1, 0, 3, 2, 4).reshape(B, T, HG_HEADS, HG_VDIM)
    o = rmsnorm(o, gnorm_w) * jax.nn.silu(g.reshape(B, T, HG_HEADS, HG_VDIM).astype(jnp.float32))
    return o.reshape(B, T, HG_WIDTH).astype(q.dtype)


def diff_attention(q, k, v, lam, lambda_init, subln_w):
    B, T, _ = q.shape
    d = DA_HEAD_DIM
    q = q.reshape(B, T, DA_HEADS, 2, d).transpose(0, 2, 3, 1, 4)
    k = k.reshape(B, T, DA_HEADS, 2, d).transpose(0, 2, 3, 1, 4)
    v = v.reshape(B, T, DA_HEADS, 2 * d).transpose(0, 2, 1, 3)
    scale = d ** -0.5
    slopes = alibi_slopes(DA_HEADS)
    pos = jnp.arange(T)
    outs = []
    for blk in range(T // Q_BLOCK):
        lo, hi = blk * Q_BLOCK, (blk + 1) * Q_BLOCK
        qb, kb, vb = q[:, :, :, lo:hi], k[:, :, :, :hi], v[:, :, :hi]
        s = jnp.einsum('bhmqd,bhmkd->bhmqk', qb, kb).astype(jnp.float32) * scale
        dist = (pos[lo:hi, None] - pos[None, :hi]).astype(jnp.float32)
        s = s - (slopes[:, None, None] * dist)[None, :, None]
        s = jnp.where(dist >= 0, s, -jnp.inf)
        p = jax.nn.softmax(s, axis=-1)
        w = p[:, :, 0] - lam * p[:, :, 1]
        outs.append(jnp.einsum('bhqk,bhkv->bhqv', w.astype(v.dtype), vb))
    o = jnp.concatenate(outs, axis=2)
    o = rmsnorm(o, subln_w) * (1.0 - lambda_init)
    return o.transpose(0, 2, 1, 3).reshape(B, T, DA_WIDTH)


def setup_inputs(seed: int = 0) -> dict:
    key = jax.random.key(seed)
    ks = jax.random.split(key, 20)
    f32 = jnp.float32
    nrm = lambda k, shape, s: jax.random.normal(k, shape, f32) * s
    return {
        "x": nrm(ks[0], (BATCH, SEQ, D_MODEL), 1.0),
        "c": nrm(ks[1], (BATCH, D_MODEL), 1.0),
        "w_ada": nrm(ks[2], (DEPTH, D_MODEL, N_MOD * D_MODEL), 0.5 * D_MODEL ** -0.5),
        "b_ada": nrm(ks[3], (DEPTH, N_MOD * D_MODEL), 0.01),
        "norm1_w": 1.0 + nrm(ks[4], (DEPTH, D_MODEL), 0.02),
        "w_in": nrm(ks[5], (DEPTH, D_MODEL, IN_WIDTH), D_MODEL ** -0.5),
        "hgrn_lb_logits": nrm(ks[6], (DEPTH + 1, HG_KWIDTH), 0.5),
        "hgrn_gnorm_w": 1.0 + nrm(ks[7], (DEPTH, HG_VDIM), 0.02),
        "diff_lambda_q1": nrm(ks[8], (DEPTH, DA_HEAD_DIM), 0.1),
        "diff_lambda_k1": nrm(ks[9], (DEPTH, DA_HEAD_DIM), 0.1),
        "diff_lambda_q2": nrm(ks[10], (DEPTH, DA_HEAD_DIM), 0.1),
        "diff_lambda_k2": nrm(ks[11], (DEPTH, DA_HEAD_DIM), 0.1),
        "diff_subln_w": 1.0 + nrm(ks[12], (DEPTH, 2 * DA_HEAD_DIM), 0.02),
        "w_out": nrm(ks[13], (DEPTH, MIX_WIDTH, D_MODEL), MIX_WIDTH ** -0.5),
        "norm2_w": 1.0 + nrm(ks[14], (DEPTH, D_MODEL), 0.02),
        "w_ffn_gate": nrm(ks[15], (DEPTH, D_MODEL, D_FF), D_MODEL ** -0.5),
        "w_ffn_up": nrm(ks[16], (DEPTH, D_MODEL, D_FF), D_MODEL ** -0.5),
        "w_ffn_down": nrm(ks[17], (DEPTH, D_FF, D_MODEL), D_FF ** -0.5),
        "final_norm_w": 1.0 + nrm(ks[18], (D_MODEL,), 0.02),
    }


def reference(x, c, w_ada, b_ada, norm1_w, w_in, hgrn_lb_logits, hgrn_gnorm_w,
              diff_lambda_q1, diff_lambda_k1, diff_lambda_q2, diff_lambda_k2, diff_subln_w,
              w_out, norm2_w, w_ffn_gate, w_ffn_up, w_ffn_down, final_norm_w):
    offs = np.cumsum(IN_SIZES)[:-1].tolist()
    lower_bounds = jnp.cumsum(jax.nn.softmax(hgrn_lb_logits.astype(jnp.float32), axis=0), axis=0)
    h = x
    for l in range(DEPTH):
        mod = jax.nn.silu(c) @ w_ada[l] + b_ada[l]
        sh1, sc1, g1, sh2, sc2, g2 = jnp.split(mod[:, None, :], N_MOD, axis=-1)
        u = rmsnorm(h, norm1_w[l]) * (1.0 + sc1) + sh1
        proj = u @ w_in[l]
        hq, hf, hi, hg, aq, ak, av = jnp.split(proj, offs, axis=-1)
        o_hg = hgrn2(hq, hf, hi, hg, lower_bounds[l], hgrn_gnorm_w[l])
        lambda_init = 0.8 - 0.6 * math.exp(-0.3 * l)
        lam = (jnp.exp(jnp.sum(diff_lambda_q1[l].astype(jnp.float32) * diff_lambda_k1[l].astype(jnp.float32)))
               - jnp.exp(jnp.sum(diff_lambda_q2[l].astype(jnp.float32) * diff_lambda_k2[l].astype(jnp.float32)))
               + lambda_init)
        o_da = diff_attention(aq, ak, av, lam, lambda_init, diff_subln_w[l])
        mix = jnp.concatenate([o_hg, o_da.astype(o_hg.dtype)], axis=-1) @ w_out[l]
        h = h + g1 * mix
        u = rmsnorm(h, norm2_w[l]) * (1.0 + sc2) + sh2
        ff = (jax.nn.silu(u @ w_ffn_gate[l]) * (u @ w_ffn_up[l])) @ w_ffn_down[l]
        h = h + g2 * ff
    return rmsnorm(h, final_norm_w)
```

```cpp
#include <hip/hip_runtime.h>
#include <hip/hip_bf16.h>
#include <cstdio>
#include <cstdint>
#include <cmath>

#ifndef MK_N_LAUNCHES
#define MK_N_LAUNCHES 1
#endif

constexpr int BATCH = 16, SEQ = 2048, DM = 1024, M = BATCH * SEQ;
constexpr int NIN = 3584;
constexpr int OFF_HQ = 0, OFF_HF = 512, OFF_HI = 1024, OFF_HG = 1536, OFF_AQ = 2048, OFF_AK = 2560, OFF_AV = 3072;
constexpr int DFF = 2816, NMOD = 6 * DM;
constexpr float EPS = 1e-6f;
constexpr float LAMBDA_INIT = 0.2f;
constexpr int NWAVES = 8, NTHR = NWAVES * 64;

constexpr size_t MiB = 1u << 20;
constexpr size_t WS_CTL = 0, CTL_ZERO_BYTES = 1 * MiB;
constexpr size_t WS_MOD = 512 * 1024;
constexpr size_t WS_WIN = 2 * MiB;
constexpr size_t WS_WOUT = 9 * MiB;
constexpr size_t WS_WGU = 11 * MiB;
constexpr size_t WS_WDN = 22 * MiB;
constexpr size_t WS_DVEC = 30 * MiB;
constexpr size_t WS_U = 32 * MiB;
constexpr size_t WS_MIX = 96 * MiB;
constexpr size_t WS_PROJ = 160 * MiB;
constexpr size_t WS_UST = 384 * MiB;
constexpr size_t WS_SST = 448 * MiB;
constexpr size_t WS_END = 512 * MiB;
constexpr int CW_BAR = 4096;

constexpr int RING_BYTES = 131072;
constexpr int LDSCTL_OFF = RING_BYTES, MISC_OFF = LDSCTL_OFF + 320;
constexpr int AUX_OFF = RING_BYTES + 512;
constexpr int LDS_BYTES = 147456;

#define GAS __attribute__((address_space(1)))
#define LAS __attribute__((address_space(3)))
typedef unsigned short bf16;
typedef unsigned v4u __attribute__((ext_vector_type(4)));
typedef unsigned v2u __attribute__((ext_vector_type(2)));
typedef float f32x4 __attribute__((ext_vector_type(4)));
typedef float f32x2 __attribute__((ext_vector_type(2)));
typedef short bf16x8 __attribute__((ext_vector_type(8)));

__device__ __forceinline__ unsigned f2bf(float f) { unsigned u = __builtin_bit_cast(unsigned, f); return (u + 0x7fffu + ((u >> 16) & 1u)) >> 16; }
__device__ __forceinline__ unsigned pk2(float lo, float hi) { return f2bf(lo) | (f2bf(hi) << 16); }
__device__ __forceinline__ float bf2f(unsigned short h) { return __builtin_bit_cast(float, (unsigned)h << 16); }
__device__ __forceinline__ float bflo(unsigned w) { return __builtin_bit_cast(float, w << 16); }
__device__ __forceinline__ float bfhi(unsigned w) { return __builtin_bit_cast(float, w & 0xffff0000u); }
__device__ __forceinline__ float wave_sum(float v) {
#pragma unroll
    for (int o = 1; o < 64; o <<= 1) v += __shfl_xor(v, o);
    return v;
}
__device__ __forceinline__ float wave_max(float v) {
#pragma unroll
    for (int o = 1; o < 64; o <<= 1) v = fmaxf(v, __shfl_xor(v, o));
    return v;
}
__device__ __forceinline__ float sigmoidf_(float x) { return 1.0f / (1.0f + __expf(-x)); }
__device__ __forceinline__ float siluf_(float x) { return x / (1.0f + __expf(-x)); }
#define LDS_WAIT() asm volatile("s_waitcnt lgkmcnt(0)" ::: "memory")
#define VM_WAIT() asm volatile("s_waitcnt vmcnt(0)" ::: "memory")

#define XB_TMO      128
#define XB_XCNT(j)  (256  + 64 * (j))
#define XB_XSUB(j)  (1280 + 64 * (j))
#define XB_XGEN(j)  (2304 + 64 * (j))
#define XB_TOP      3328
#define XB_TOPGEN   3392
#define XCD_BAR_WORDS 3456
#define XB_SPIN_CAP (1u << 20)
__device__ __forceinline__ unsigned xb_ld(unsigned* p)              { return __hip_atomic_load(p, __ATOMIC_RELAXED, __HIP_MEMORY_SCOPE_AGENT); }
__device__ __forceinline__ unsigned xb_add(unsigned* p, unsigned v) { return __hip_atomic_fetch_add(p, v, __ATOMIC_RELAXED, __HIP_MEMORY_SCOPE_AGENT); }
__device__ __forceinline__ unsigned xb_xcc_id() { return (unsigned)__builtin_amdgcn_s_getreg((3 << 11) | 20) & 0xFu; }
#define XB_SPIN(cond, bar) do { unsigned _sp = 0; while (cond) { __builtin_amdgcn_s_sleep(1); \
    if ((++_sp & 255u) == 0u) { if (xb_ld(&(bar)[XB_TMO])) break; if (_sp > XB_SPIN_CAP) { atomicAdd(&(bar)[XB_TMO], 1u); break; } } } } while (0)
struct XcdBarrier { unsigned* bar; unsigned x; volatile LAS unsigned* st; };
__device__ __forceinline__ XcdBarrier xcd_barrier_post(unsigned* bar, volatile LAS unsigned* st) {
    XcdBarrier b; b.bar = bar; b.x = xb_xcc_id(); b.st = st;
    if (threadIdx.x == 0) (void)xb_add(&bar[XB_XCNT(b.x)], 1u);
    return b;
}
__device__ __forceinline__ void xcd_barrier_complete(unsigned* bar, unsigned x, unsigned& nloc, unsigned& nx) {
    const unsigned G = gridDim.x * gridDim.y * gridDim.z;
    unsigned sum, cnt, mine, sp = 0u;
    for (;;) {
        sum = 0u; cnt = 0u; mine = 0u;
#pragma unroll
        for (unsigned j = 0; j < 16; ++j) { const unsigned c = xb_ld(&bar[XB_XCNT(j)]); sum += c; cnt += (c > 0u) ? 1u : 0u; mine = (j == x) ? c : mine; }
        if (sum == G) break;
        __builtin_amdgcn_s_sleep(1);
        if ((++sp & 255u) == 0u) { if (xb_ld(&bar[XB_TMO])) break; if (sp > XB_SPIN_CAP) { atomicAdd(&bar[XB_TMO], 1u); break; } }
    }
    nloc = mine > 0u ? mine : 1u; nx = cnt > 0u ? cnt : 1u;
}
__device__ __forceinline__ void xcd_barrier(const XcdBarrier& b) {
    asm volatile("s_waitcnt vmcnt(0)" ::: "memory");
    __syncthreads();
    if (threadIdx.x == 0) {
        unsigned* bar = b.bar;
        __builtin_amdgcn_s_waitcnt(0);
        unsigned nloc = b.st[0], nx = b.st[1];
        if (nloc == 0u) { xcd_barrier_complete(bar, b.x, nloc, nx); b.st[0] = nloc; b.st[1] = nx; }
        const unsigned old = xb_add(&bar[XB_XSUB(b.x)], 1u);
        const unsigned gen = old / nloc;
        if (old + 1u == (gen + 1u) * nloc) {
            __builtin_amdgcn_fence(__ATOMIC_RELEASE, "agent");
            asm volatile("s_waitcnt vmcnt(0)" ::: "memory");
            const unsigned og = xb_add(&bar[XB_TOP], 1u);
            const unsigned tg = og / nx;
            if (og + 1u == (tg + 1u) * nx) xb_add(&bar[XB_TOPGEN], 1u);
            else XB_SPIN(xb_ld(&bar[XB_TOPGEN]) == tg, bar);
            __builtin_amdgcn_fence(__ATOMIC_ACQUIRE, "agent");
            xb_add(&bar[XB_XGEN(b.x)], 1u);
            asm volatile("s_waitcnt vmcnt(0)" ::: "memory");
        } else {
            XB_SPIN(xb_ld(&bar[XB_XGEN(b.x)]) == gen, bar);
            __builtin_amdgcn_fence(__ATOMIC_ACQUIRE, "agent");
            asm volatile("s_waitcnt vmcnt(0)" ::: "memory");
        }
    }
    __syncthreads();
}

struct Frame {
    LAS unsigned char* lds;
    int tid, lane, wave, G, vcu;
    const float *x, *c, *w_ada, *b_ada, *norm1_w, *w_in, *lb_logits, *gnorm_w, *lq1, *lk1, *lq2, *lk2, *subln_w, *w_out, *norm2_w, *w_gate, *w_up, *w_down, *final_w;
    float* out; unsigned char* ws;
    float* MOD; bf16 *WIN, *WOUT, *WGU, *WDN, *U, *MIX, *PROJ, *ACT;
};

__device__ __forceinline__ void p0_transpose_item(const float* W, int K, int N, bf16* WT, int gstride, int goff, LAS float* scr, int item, int lane) {
    const int nblk = N / 32, kb = item / nblk, nb = item % nblk, k0 = 64 * kb, n0 = 32 * nb;
#pragma unroll 8
    for (int i = 0; i < 32; ++i) { const int kk = 2 * i + (lane >> 5); scr[kk * 33 + (lane & 31)] = W[(size_t)(k0 + kk) * N + n0 + (lane & 31)]; }
    LDS_WAIT(); asm volatile("" ::: "memory");
    const int c = lane & 7;
    const int rbase = (n0 / 128) * gstride + (n0 % 128) + goff;
#pragma unroll
    for (int j = 0; j < 4; ++j) { const int n = (lane >> 3) + 8 * j; const LAS float* s = scr + (8 * c) * 33 + n;
        v4u o; o.x = pk2(s[0 * 33], s[1 * 33]); o.y = pk2(s[2 * 33], s[3 * 33]); o.z = pk2(s[4 * 33], s[5 * 33]); o.w = pk2(s[6 * 33], s[7 * 33]);
        *(GAS v4u*)(WT + (size_t)(rbase + n) * K + k0 + 8 * c) = o; }
    LDS_WAIT(); asm volatile("" ::: "memory");
}
__device__ __forceinline__ void phase_wconv(Frame& F) {
    LAS float* scr = (LAS float*)(F.lds + F.wave * 16384);
    const int gw = F.vcu * NWAVES + F.wave, NGW = F.G * NWAVES;
    constexpr int I_IN = (DM / 64) * (NIN / 32), I_OUT = (DM / 64) * (DM / 32), I_G = (DM / 64) * (DFF / 32), I_DN = (DFF / 64) * (DM / 32);
    constexpr int NITEMS = I_IN + I_OUT + 2 * I_G + I_DN;
    for (int it = gw; it < NITEMS; it += NGW) {
        int r = it;
        if (r < I_IN) { p0_transpose_item(F.w_in, DM, NIN, F.WIN, 128, 0, scr, r, F.lane); continue; } r -= I_IN;
        if (r < I_OUT) { p0_transpose_item(F.w_out, DM, DM, F.WOUT, 128, 0, scr, r, F.lane); continue; } r -= I_OUT;
        if (r < I_G) { p0_transpose_item(F.w_gate, DM, DFF, F.WGU, 256, 0, scr, r, F.lane); continue; } r -= I_G;
        if (r < I_G) { p0_transpose_item(F.w_up, DM, DFF, F.WGU, 256, 128, scr, r, F.lane); continue; } r -= I_G;
        p0_transpose_item(F.w_down, DFF, DM, F.WDN, 128, 0, scr, r, F.lane);
    }
}
__device__ __forceinline__ void phase_mod(Frame& F) {
    LAS float* red = (LAS float*)F.lds;
    LAS float* sil = (LAS float*)(F.lds + AUX_OFF) + F.wave * 256;
    for (int it = F.vcu; it < 24 * 8; it += F.G) {
        const int cg = it % 24, s = it / 24, k0 = s * 128 + F.wave * 16;
#pragma unroll
        for (int j = 0; j < 4; ++j) { const int e = F.lane * 4 + j, kk = e >> 4, b = e & 15; sil[kk * 16 + b] = siluf_(F.c[b * DM + k0 + kk]); }
        LDS_WAIT(); asm volatile("" ::: "memory");
        f32x4 acc[16];
#pragma unroll
        for (int b = 0; b < 16; ++b) acc[b] = (f32x4){0.f, 0.f, 0.f, 0.f};
        const GAS f32x4* wp = (const GAS f32x4*)(F.w_ada + (size_t)k0 * NMOD + cg * 256) + F.lane;
#pragma unroll 4
        for (int kk = 0; kk < 16; ++kk) { const f32x4 w = wp[(size_t)kk * (NMOD / 4)];
#pragma unroll
            for (int b = 0; b < 16; ++b) { const float sv = sil[kk * 16 + b]; acc[b] += w * sv; } }
#pragma unroll
        for (int b = 0; b < 16; ++b) *(LAS f32x4*)(red + (F.wave * 16 + b) * 256 + F.lane * 4) = acc[b];
        __syncthreads();
#pragma unroll
        for (int o = 0; o < 8; ++o) { const int idx = F.tid + NTHR * o, b = idx >> 8, col = idx & 255; float sum = 0.f;
#pragma unroll
            for (int w = 0; w < 8; ++w) sum += red[(w * 16 + b) * 256 + col];
            if (s == 0) sum += F.b_ada[cg * 256 + col];
            atomicAdd(F.MOD + b * NMOD + cg * 256 + col, sum); }
        __syncthreads();
    }
}
__device__ __forceinline__ void phase_modnorm(Frame& F, const float* src, const float* nw, int sh_off, int sc_off) {
    const int gw = F.vcu * NWAVES + F.wave, NGW = F.G * NWAVES;
    constexpr int RPW = 16;
    for (int blk = gw; blk < M / RPW; blk += NGW) {
        const int m0 = blk * RPW, b = m0 / SEQ;
        f32x4 a[4], sh[4];
#pragma unroll
        for (int j = 0; j < 4; ++j) { const int col = 256 * j + 4 * F.lane;
            const f32x4 w = *(const GAS f32x4*)(nw + col), sc = *(const GAS f32x4*)(F.MOD + b * NMOD + sc_off + col);
            sh[j] = *(const GAS f32x4*)(F.MOD + b * NMOD + sh_off + col); a[j] = w * (sc + 1.0f); }
        for (int r = 0; r < RPW; ++r) {
            const GAS f32x4* xr = (const GAS f32x4*)(src + (size_t)(m0 + r) * DM) + F.lane;
            f32x4 v[4]; float s = 0.f;
#pragma unroll
            for (int j = 0; j < 4; ++j) { v[j] = xr[64 * j]; s += (v[j].x * v[j].x + v[j].y * v[j].y) + (v[j].z * v[j].z + v[j].w * v[j].w); }
            const float rstd = 1.0f / sqrtf(wave_sum(s) * (1.0f / DM) + EPS);
            GAS v2u* o8 = (GAS v2u*)(F.U + (size_t)(m0 + r) * DM) + F.lane;
#pragma unroll
            for (int j = 0; j < 4; ++j) { const f32x4 y = v[j] * rstd * a[j] + sh[j]; v2u w; w.x = pk2(y.x, y.y); w.y = pk2(y.z, y.w); o8[64 * j] = w; }
        }
    }
}
__device__ __forceinline__ void phase_final_norm(Frame& F) {
    const int gw = F.vcu * NWAVES + F.wave, NGW = F.G * NWAVES;
    f32x4 w[4];
#pragma unroll
    for (int j = 0; j < 4; ++j) w[j] = *(const GAS f32x4*)(F.final_w + 256 * j + 4 * F.lane);
    for (int m = gw; m < M; m += NGW) {
        GAS f32x4* xr = (GAS f32x4*)(F.out + (size_t)m * DM) + F.lane;
        f32x4 v[4]; float s = 0.f;
#pragma unroll
        for (int j = 0; j < 4; ++j) { v[j] = xr[64 * j]; s += (v[j].x * v[j].x + v[j].y * v[j].y) + (v[j].z * v[j].z + v[j].w * v[j].w); }
        const float rstd = 1.0f / sqrtf(wave_sum(s) * (1.0f / DM) + EPS);
#pragma unroll
        for (int j = 0; j < 4; ++j) xr[64 * j] = v[j] * rstd * w[j];
    }
}
template <class Epi>
__device__ __forceinline__ void gemm_simple(Frame& F, const bf16* A, const bf16* Bt, int Mr, int N, int K, const Epi& E) {
    const int gw = F.vcu * NWAVES + F.wave, NGW = F.G * NWAVES;
    const int r16 = F.lane & 15, q = F.lane >> 4;
    const int ntn = N / 64, ntiles = (Mr / 64) * ntn;
    for (int t = gw; t < ntiles; t += NGW) {
        const int tm = t / ntn, tn = t % ntn;
        f32x4 acc[4][4];
#pragma unroll
        for (int i = 0; i < 4; ++i)
#pragma unroll
            for (int j = 0; j < 4; ++j) acc[i][j] = (f32x4){0.f, 0.f, 0.f, 0.f};
        const bf16* ap = A + (size_t)(tm * 64 + r16) * K + q * 8;
        const bf16* bp = Bt + (size_t)(tn * 64 + r16) * K + q * 8;
        for (int k0 = 0; k0 < K; k0 += 32) {
            bf16x8 a[4], b[4];
#pragma unroll
            for (int i = 0; i < 4; ++i) { a[i] = *(const GAS bf16x8*)(ap + (size_t)i * 16 * K + k0); b[i] = *(const GAS bf16x8*)(bp + (size_t)i * 16 * K + k0); }
#pragma unroll
            for (int i = 0; i < 4; ++i)
#pragma unroll
                for (int j = 0; j < 4; ++j) acc[i][j] = __builtin_amdgcn_mfma_f32_16x16x32_bf16(a[i], b[j], acc[i][j], 0, 0, 0);
        }
#pragma unroll
        for (int i = 0; i < 4; ++i)
#pragma unroll
            for (int j = 0; j < 4; ++j)
#pragma unroll
                for (int e = 0; e < 4; ++e) E(tm * 64 + i * 16 + q * 4 + e, tn * 64 + j * 16 + r16, acc[i][j][e]);
    }
}
struct EpiProjS { bf16* O; __device__ __forceinline__ void operator()(int r, int c, float v) const { O[(size_t)r * NIN + c] = (bf16)f2bf(v); } };
struct EpiResS { const float* base; const float* gate; float* O;
    __device__ __forceinline__ void operator()(int r, int c, float v) const { const int b = r / SEQ; O[(size_t)r * DM + c] = base[(size_t)r * DM + c] + gate[b * NMOD + c] * v; } };

__device__ __forceinline__ void phase_hgrn_naive(Frame& F) {
    LAS float* qs = (LAS float*)F.lds;
    LAS float* fs = qs + 128;
    LAS float* red = fs + 128;
    float* OR = (float*)(F.ws + WS_UST);
    const int v = F.tid & 127, ks = F.tid >> 7;
    for (int it = F.vcu; it < BATCH * 4; it += F.G) {
        const int b = it >> 2, h = it & 3;
        const float a0 = F.lb_logits[h * 128 + v], a1 = F.lb_logits[512 + h * 128 + v];
        const float lb = 1.0f / (1.0f + __expf(a1 - a0));
        float S[32];
#pragma unroll
        for (int i = 0; i < 32; ++i) S[i] = 0.f;
        for (int t = 0; t < SEQ; ++t) {
            const size_t row = (size_t)(b * SEQ + t) * NIN;
            const float iv = bf2f(F.PROJ[row + OFF_HI + h * 128 + v]);
            if (ks == 0) { const float qv = bf2f(F.PROJ[row + OFF_HQ + h * 128 + v]), fl = bf2f(F.PROJ[row + OFF_HF + h * 128 + v]);
                qs[v] = qv; fs[v] = lb + (1.0f - lb) * sigmoidf_(fl); }
            __syncthreads();
            float part = 0.f;
#pragma unroll
            for (int i = 0; i < 32; ++i) { const float f = fs[ks * 32 + i], qv = qs[ks * 32 + i]; S[i] = f * S[i] + (1.0f - f) * iv; part += qv * S[i]; }
            red[ks * 128 + v] = part;
            __syncthreads();
            if (ks == 0) OR[(size_t)(b * SEQ + t) * 512 + h * 128 + v] = (red[v] + red[128 + v]) + (red[256 + v] + red[384 + v]);
        }
        VM_WAIT(); __syncthreads();
        const float gw0 = F.gnorm_w[2 * F.lane], gw1 = F.gnorm_w[2 * F.lane + 1];
        for (int t = F.wave; t < SEQ; t += NWAVES) {
            const size_t m = (size_t)(b * SEQ + t);
            const f32x2 o = *(const GAS f32x2*)(OR + m * 512 + h * 128 + 2 * F.lane);
            const float rstd = 1.0f / sqrtf(wave_sum(o.x * o.x + o.y * o.y) * (1.0f / 128.0f) + EPS);
            const unsigned gg = *(const GAS unsigned*)(F.PROJ + m * NIN + OFF_HG + h * 128 + 2 * F.lane);
            *(GAS unsigned*)(F.MIX + m * DM + h * 128 + 2 * F.lane) = pk2(o.x * rstd * gw0 * siluf_(bflo(gg)), o.y * rstd * gw1 * siluf_(bfhi(gg)));
        }
        __syncthreads();
    }
}
__device__ __forceinline__ float diff_lambda(const Frame& F) {
    float s1 = 0.f, s2 = 0.f;
    for (int i = 0; i < 64; ++i) { s1 += F.lq1[i] * F.lk1[i]; s2 += F.lq2[i] * F.lk2[i]; }
    return __expf(s1) - __expf(s2) + LAMBDA_INIT;
}
__device__ __forceinline__ void phase_attn_naive(Frame& F) {
    LAS float* qf = (LAS float*)F.lds;
    LAS float* wbuf = qf + 128;
    LAS float* pbuf = wbuf + 2048;
    LAS float* redm = pbuf + 2048;
    LAS float* part = redm + 64;
    const float lam = diff_lambda(F);
    for (int it = F.vcu; it < M * 4; it += F.G) {
        const int h = it & 3, m = it >> 2, b = m / SEQ, t = m % SEQ;
        const float slope = exp2f(-2.0f * (h + 1));
        if (F.tid < 128) qf[F.tid] = bf2f(F.PROJ[(size_t)m * NIN + OFF_AQ + h * 128 + F.tid]) * 0.125f;
        __syncthreads();
        float s1[4], s2[4]; float m1 = -INFINITY, m2 = -INFINITY;
#pragma unroll
        for (int j = 0; j < 4; ++j) { const int s = F.tid + NTHR * j; s1[j] = -INFINITY; s2[j] = -INFINITY;
            if (s <= t) { const bf16* kp = F.PROJ + (size_t)(b * SEQ + s) * NIN + OFF_AK + h * 128; float d1 = 0.f, d2 = 0.f;
#pragma unroll
                for (int i = 0; i < 8; ++i) { const v4u w1 = *(const GAS v4u*)(kp + 8 * i), w2 = *(const GAS v4u*)(kp + 64 + 8 * i);
                    d1 += bflo(w1.x) * qf[8 * i] + bfhi(w1.x) * qf[8 * i + 1] + bflo(w1.y) * qf[8 * i + 2] + bfhi(w1.y) * qf[8 * i + 3] + bflo(w1.z) * qf[8 * i + 4] + bfhi(w1.z) * qf[8 * i + 5] + bflo(w1.w) * qf[8 * i + 6] + bfhi(w1.w) * qf[8 * i + 7];
                    d2 += bflo(w2.x) * qf[64 + 8 * i] + bfhi(w2.x) * qf[64 + 8 * i + 1] + bflo(w2.y) * qf[64 + 8 * i + 2] + bfhi(w2.y) * qf[64 + 8 * i + 3] + bflo(w2.z) * qf[64 + 8 * i + 4] + bfhi(w2.z) * qf[64 + 8 * i + 5] + bflo(w2.w) * qf[64 + 8 * i + 6] + bfhi(w2.w) * qf[64 + 8 * i + 7]; }
                const float bias = slope * (float)(t - s); s1[j] = d1 - bias; s2[j] = d2 - bias; m1 = fmaxf(m1, s1[j]); m2 = fmaxf(m2, s2[j]); } }
        m1 = wave_max(m1); m2 = wave_max(m2);
        if (F.lane == 0) { redm[F.wave] = m1; redm[8 + F.wave] = m2; }
        __syncthreads();
        m1 = redm[0]; m2 = redm[8];
#pragma unroll
        for (int w = 1; w < 8; ++w) { m1 = fmaxf(m1, redm[w]); m2 = fmaxf(m2, redm[8 + w]); }
        float l1 = 0.f, l2 = 0.f;
#pragma unroll
        for (int j = 0; j < 4; ++j) { const int s = F.tid + NTHR * j; if (s <= t) { const float p1 = __expf(s1[j] - m1), p2 = __expf(s2[j] - m2); l1 += p1; l2 += p2; wbuf[s] = p1; pbuf[s] = p2; } }
        l1 = wave_sum(l1); l2 = wave_sum(l2);
        if (F.lane == 0) { redm[16 + F.wave] = l1; redm[24 + F.wave] = l2; }
        __syncthreads();
        l1 = 0.f; l2 = 0.f;
#pragma unroll
        for (int w = 0; w < 8; ++w) { l1 += redm[16 + w]; l2 += redm[24 + w]; }
        const float i1 = 1.0f / l1, i2 = lam / l2;
        const int v = F.tid & 127, sp = F.tid >> 7; float acc = 0.f;
        const bf16* vp = F.PROJ + (size_t)(b * SEQ) * NIN + OFF_AV + h * 128 + v;
        for (int s = sp; s <= t; s += 4) acc += (wbuf[s] * i1 - pbuf[s] * i2) * bf2f(vp[(size_t)s * NIN]);
        part[sp * 128 + v] = acc;
        __syncthreads();
        if (F.tid < 128) { const float o = (part[v] + part[128 + v]) + (part[256 + v] + part[384 + v]);
            float ss = wave_sum(o * o); if (F.lane == 0) redm[32 + F.wave] = ss;
            qf[v] = o; }
        __syncthreads();
        if (F.tid < 128) { const float ss = redm[32] + redm[33]; const float rstd = 1.0f / sqrtf(ss * (1.0f / 128.0f) + EPS);
            F.MIX[(size_t)m * DM + 512 + h * 128 + v] = (bf16)f2bf(qf[v] * rstd * F.subln_w[v] * (1.0f - LAMBDA_INIT)); }
        __syncthreads();
    }
}
struct EpiGateS { bf16* O; __device__ __forceinline__ void operator()(int r, int c, float v) const { O[(size_t)r * DFF + c] = (bf16)f2bf(v); } };

enum { PH_PRO = 0, PH_NORM1, PH_INPROJ, PH_MIXER, PH_OUTPROJ, PH_NORM2, PH_FFN1, PH_FFN2, PH_FINAL, PH_COUNT };
struct Args { const float* in[19]; float* out; unsigned char* ws; int ph_lo, ph_hi; };

__global__ void __launch_bounds__(NTHR, 2) fwd(Args args) {
    extern __shared__ __attribute__((aligned(16))) unsigned char lds[];
    Frame F;
    F.lds = (LAS unsigned char*)lds;
    F.tid = threadIdx.x; F.lane = F.tid & 63; F.wave = __builtin_amdgcn_readfirstlane(F.tid >> 6);
    F.G = gridDim.x; { const int bx = blockIdx.x; F.vcu = (F.G % 8 == 0) ? (bx % 8) * (F.G / 8) + bx / 8 : bx; }
    F.x = args.in[0]; F.c = args.in[1]; F.w_ada = args.in[2]; F.b_ada = args.in[3]; F.norm1_w = args.in[4]; F.w_in = args.in[5]; F.lb_logits = args.in[6]; F.gnorm_w = args.in[7];
    F.lq1 = args.in[8]; F.lk1 = args.in[9]; F.lq2 = args.in[10]; F.lk2 = args.in[11]; F.subln_w = args.in[12]; F.w_out = args.in[13]; F.norm2_w = args.in[14];
    F.w_gate = args.in[15]; F.w_up = args.in[16]; F.w_down = args.in[17]; F.final_w = args.in[18];
    F.out = args.out; F.ws = args.ws;
    F.MOD = (float*)(args.ws + WS_MOD); F.WIN = (bf16*)(args.ws + WS_WIN); F.WOUT = (bf16*)(args.ws + WS_WOUT); F.WGU = (bf16*)(args.ws + WS_WGU); F.WDN = (bf16*)(args.ws + WS_WDN);
    F.U = (bf16*)(args.ws + WS_U); F.MIX = (bf16*)(args.ws + WS_MIX); F.PROJ = (bf16*)(args.ws + WS_PROJ); F.ACT = (bf16*)(args.ws + WS_PROJ);
    for (int u = F.tid; u < (LDS_BYTES - LDSCTL_OFF) / 4; u += NTHR) ((LAS unsigned*)(F.lds + LDSCTL_OFF))[u] = 0u;
    __syncthreads();
    unsigned* ctl = (unsigned*)(args.ws + WS_CTL);
    XcdBarrier bar; bar.bar = ctl + CW_BAR; bar.x = 0; bar.st = nullptr;
    if (MK_N_LAUNCHES == 1) bar = xcd_barrier_post(ctl + CW_BAR, (volatile LAS unsigned*)(F.lds + MISC_OFF) + 8);
    const int lo = args.ph_lo, hi = args.ph_hi;
#define IN(k) (lo <= (k) && (k) < hi)
#define SEAM(k) do { if (IN(k) && IN((k) + 1)) xcd_barrier(bar); } while (0)

    if (IN(PH_PRO)) { phase_wconv(F); __syncthreads(); phase_mod(F); }
    SEAM(PH_PRO);
    if (IN(PH_NORM1)) phase_modnorm(F, F.x, F.norm1_w, 0, DM);
    SEAM(PH_NORM1);
    if (IN(PH_INPROJ)) { EpiProjS E{F.PROJ}; gemm_simple(F, F.U, F.WIN, M, NIN, DM, E); }
    SEAM(PH_INPROJ);
    if (IN(PH_MIXER)) { phase_hgrn_naive(F); phase_attn_naive(F); }
    SEAM(PH_MIXER);
    if (IN(PH_OUTPROJ)) { EpiResS E{F.x, F.MOD + 2 * DM, F.out}; gemm_simple(F, F.MIX, F.WOUT, M, DM, DM, E); }
    SEAM(PH_OUTPROJ);
    if (IN(PH_NORM2)) phase_modnorm(F, F.out, F.norm2_w, 3 * DM, 4 * DM);
    SEAM(PH_NORM2);
    if (IN(PH_FFN1)) {
        const int gw = F.vcu * NWAVES + F.wave, NGW = F.G * NWAVES; const int r16 = F.lane & 15, q = F.lane >> 4;
        const int ntn = DFF / 64, ntiles = (M / 64) * ntn;
        for (int t = gw; t < ntiles; t += NGW) {
            const int tm = t / ntn, tn = t % ntn;
            const int grow = ((tn * 64) / 128) * 256 + ((tn * 64) % 128);
            f32x4 ag[4][4], au[4][4];
#pragma unroll
            for (int i = 0; i < 4; ++i)
#pragma unroll
                for (int j = 0; j < 4; ++j) { ag[i][j] = (f32x4){0.f, 0.f, 0.f, 0.f}; au[i][j] = (f32x4){0.f, 0.f, 0.f, 0.f}; }
            const bf16* ap = F.U + (size_t)(tm * 64 + r16) * DM + q * 8;
            const bf16* gp = F.WGU + (size_t)(grow + r16) * DM + q * 8;
            for (int k0 = 0; k0 < DM; k0 += 32) {
                bf16x8 a[4], g[4], u[4];
#pragma unroll
                for (int i = 0; i < 4; ++i) { a[i] = *(const GAS bf16x8*)(ap + (size_t)i * 16 * DM + k0); g[i] = *(const GAS bf16x8*)(gp + (size_t)i * 16 * DM + k0); u[i] = *(const GAS bf16x8*)(gp + (size_t)(128 + i * 16) * DM + k0); }
#pragma unroll
                for (int i = 0; i < 4; ++i)
#pragma unroll
                    for (int j = 0; j < 4; ++j) { ag[i][j] = __builtin_amdgcn_mfma_f32_16x16x32_bf16(a[i], g[j], ag[i][j], 0, 0, 0); au[i][j] = __builtin_amdgcn_mfma_f32_16x16x32_bf16(a[i], u[j], au[i][j], 0, 0, 0); }
            }
#pragma unroll
            for (int i = 0; i < 4; ++i)
#pragma unroll
                for (int j = 0; j < 4; ++j)
#pragma unroll
                    for (int e = 0; e < 4; ++e) { const int r = tm * 64 + i * 16 + q * 4 + e, c = tn * 64 + j * 16 + r16;
                        F.ACT[(size_t)r * DFF + c] = (bf16)f2bf(siluf_(ag[i][j][e]) * au[i][j][e]); }
        }
    }
    SEAM(PH_FFN1);
    if (IN(PH_FFN2)) { EpiResS E{F.out, F.MOD + 5 * DM, F.out}; gemm_simple(F, F.ACT, F.WDN, M, DM, DFF, E); }
    SEAM(PH_FFN2);
    if (IN(PH_FINAL)) phase_final_norm(F);
#undef IN
#undef SEAM
}

extern "C" void kernel_launch(void* const* d_in, const int* in_sizes, int n_in, void* d_out, int out_size, void* d_ws, size_t ws_size, hipStream_t stream) {
    static int grid = 0;
    if (grid == 0) {
        if (n_in != 19 || in_sizes[0] != M * DM || out_size != M * DM || ws_size < WS_END) { fprintf(stderr, "kernel_launch: unexpected shapes (n_in %d in0 %d out %d ws %zu)\n", n_in, n_in > 0 ? in_sizes[0] : -1, out_size, ws_size); grid = -1; return; }
        int dev = 0, cus = 0;
        if (hipGetDevice(&dev) != hipSuccess || hipDeviceGetAttribute(&cus, hipDeviceAttributeMultiprocessorCount, dev) != hipSuccess) { grid = -1; return; }
        if (hipFuncSetAttribute((const void*)fwd, hipFuncAttributeMaxDynamicSharedMemorySize, LDS_BYTES) != hipSuccess) { fprintf(stderr, "kernel_launch: hipFuncSetAttribute failed\n"); grid = -1; return; }
        int per_cu = 0;
        if (hipOccupancyMaxActiveBlocksPerMultiprocessor(&per_cu, (const void*)fwd, NTHR, LDS_BYTES) != hipSuccess || per_cu < 1) fprintf(stderr, "kernel_launch: occupancy query reports %d\n", per_cu);
        (void)hipGetLastError();
        grid = cus;
    }
    if (grid < 0) return;
    (void)hipMemsetAsync((char*)d_ws + WS_CTL, 0, CTL_ZERO_BYTES, stream);
    Args a{};
    for (int i = 0; i < 19; ++i) a.in[i] = (const float*)d_in[i];
    a.out = (float*)d_out; a.ws = (unsigned char*)d_ws;
    if (MK_N_LAUNCHES == 1) { a.ph_lo = 0; a.ph_hi = PH_COUNT; hipLaunchKernelGGL(fwd, dim3(grid), dim3(NTHR), LDS_BYTES, stream, a); }
    else for (int p = 0; p < PH_COUNT; ++p) { a.ph_lo = p; a.ph_hi = p + 1; hipLaunchKernelGGL(fwd, dim3(grid), dim3(NTHR), LDS_BYTES, stream, a); }
}
```

```cpp
#include <hip/hip_runtime.h>
#include <hip/hip_bf16.h>
#include <cstdio>
#include <cstdint>
#include <cmath>

#ifndef PROBE
#define PROBE 0
#endif
#ifndef PROBE_LO
#define PROBE_LO 0
#define PROBE_HI 512
#define PROBE_TMIN 0
#endif
#ifndef FAST_HGRN
#define FAST_HGRN 1
#endif
#ifndef FAST_ATTN
#define FAST_ATTN 1
#endif
#ifndef FAST_GEMM
#define FAST_GEMM 1
#endif
#ifndef MK_N_LAUNCHES
#define MK_N_LAUNCHES 1
#endif

constexpr int BATCH = 16, SEQ = 2048, DM = 1024, M = BATCH * SEQ;
constexpr int NIN = 3584;
constexpr int OFF_HQ = 0, OFF_HF = 512, OFF_HI = 1024, OFF_HG = 1536, OFF_AQ = 2048, OFF_AK = 2560, OFF_AV = 3072;
constexpr int DFF = 2816, NMOD = 6 * DM;
constexpr float EPS = 1e-6f;
constexpr float LAMBDA_INIT = 0.2f;
constexpr int NWAVES = 8, NTHR = NWAVES * 64;

constexpr size_t MiB = 1u << 20;
constexpr size_t WS_CTL = 0, CTL_ZERO_BYTES = 1 * MiB;
constexpr size_t WS_MOD = 512 * 1024;
constexpr size_t WS_WIN = 2 * MiB;
constexpr size_t WS_WOUT = 9 * MiB;
constexpr size_t WS_WGU = 11 * MiB;
constexpr size_t WS_WDN = 22 * MiB;
constexpr size_t WS_DVEC = 30 * MiB;
constexpr size_t WS_U = 32 * MiB;
constexpr size_t WS_MIX = 96 * MiB;
constexpr size_t WS_PROJ = 160 * MiB;
constexpr size_t WS_UST = 384 * MiB;
constexpr size_t WS_SST = 448 * MiB;
constexpr size_t WS_END = 512 * MiB;
constexpr int CW_DIAG = 64;
constexpr int CW_BAR = 4096;

constexpr int RING_BYTES = 131072;
constexpr int LDSCTL_OFF = RING_BYTES, MISC_OFF = LDSCTL_OFF + 320;
constexpr int AUX_OFF = RING_BYTES + 512;
constexpr int LDS_BYTES = 147456;

#define GAS __attribute__((address_space(1)))
#define LAS __attribute__((address_space(3)))
typedef unsigned short bf16;
typedef unsigned v4u __attribute__((ext_vector_type(4)));
typedef unsigned v2u __attribute__((ext_vector_type(2)));
typedef float f32x4 __attribute__((ext_vector_type(4)));
typedef float f32x2 __attribute__((ext_vector_type(2)));
typedef short bf16x8 __attribute__((ext_vector_type(8)));

__device__ __forceinline__ unsigned f2bf(float f) { unsigned u = __builtin_bit_cast(unsigned, f); return (u + 0x7fffu + ((u >> 16) & 1u)) >> 16; }
__device__ __forceinline__ unsigned pk2(float lo, float hi) { return f2bf(lo) | (f2bf(hi) << 16); }
__device__ __forceinline__ float bf2f(unsigned short h) { return __builtin_bit_cast(float, (unsigned)h << 16); }
__device__ __forceinline__ float bflo(unsigned w) { return __builtin_bit_cast(float, w << 16); }
__device__ __forceinline__ float bfhi(unsigned w) { return __builtin_bit_cast(float, w & 0xffff0000u); }
__device__ __forceinline__ float wave_sum(float v) {
#pragma unroll
    for (int o = 1; o < 64; o <<= 1) v += __shfl_xor(v, o);
    return v;
}
__device__ __forceinline__ float wave_max(float v) {
#pragma unroll
    for (int o = 1; o < 64; o <<= 1) v = fmaxf(v, __shfl_xor(v, o));
    return v;
}
__device__ __forceinline__ float sigmoidf_(float x) { return 1.0f / (1.0f + __expf(-x)); }
__device__ __forceinline__ float siluf_(float x) { return x / (1.0f + __expf(-x)); }
#define LDS_WAIT() asm volatile("s_waitcnt lgkmcnt(0)" ::: "memory")
#define VM_WAIT() asm volatile("s_waitcnt vmcnt(0)" ::: "memory")

#define XB_TMO      128
#define XB_XCNT(j)  (256  + 64 * (j))
#define XB_XSUB(j)  (1280 + 64 * (j))
#define XB_XGEN(j)  (2304 + 64 * (j))
#define XB_TOP      3328
#define XB_TOPGEN   3392
#define XCD_BAR_WORDS 3456
#define XB_SPIN_CAP (1u << 20)
__device__ __forceinline__ unsigned xb_ld(unsigned* p)              { return __hip_atomic_load(p, __ATOMIC_RELAXED, __HIP_MEMORY_SCOPE_AGENT); }
__device__ __forceinline__ unsigned xb_add(unsigned* p, unsigned v) { return __hip_atomic_fetch_add(p, v, __ATOMIC_RELAXED, __HIP_MEMORY_SCOPE_AGENT); }
__device__ __forceinline__ unsigned xb_xcc_id() { return (unsigned)__builtin_amdgcn_s_getreg((3 << 11) | 20) & 0xFu; }
#define XB_SPIN(cond, bar) do { unsigned _sp = 0; while (cond) { __builtin_amdgcn_s_sleep(1); \
    if ((++_sp & 255u) == 0u) { if (xb_ld(&(bar)[XB_TMO])) break; if (_sp > XB_SPIN_CAP) { atomicAdd(&(bar)[XB_TMO], 1u); break; } } } } while (0)
struct XcdBarrier { unsigned* bar; unsigned x; volatile LAS unsigned* st; };
__device__ __forceinline__ XcdBarrier xcd_barrier_post(unsigned* bar, volatile LAS unsigned* st) {
    XcdBarrier b; b.bar = bar; b.x = xb_xcc_id(); b.st = st;
    if (threadIdx.x == 0) (void)xb_add(&bar[XB_XCNT(b.x)], 1u);
    return b;
}
__device__ __forceinline__ void xcd_barrier_complete(unsigned* bar, unsigned x, unsigned& nloc, unsigned& nx) {
    const unsigned G = gridDim.x * gridDim.y * gridDim.z;
    unsigned sum, cnt, mine, sp = 0u;
    for (;;) {
        sum = 0u; cnt = 0u; mine = 0u;
#pragma unroll
        for (unsigned j = 0; j < 16; ++j) { const unsigned c = xb_ld(&bar[XB_XCNT(j)]); sum += c; cnt += (c > 0u) ? 1u : 0u; mine = (j == x) ? c : mine; }
        if (sum == G) break;
        __builtin_amdgcn_s_sleep(1);
        if ((++sp & 255u) == 0u) { if (xb_ld(&bar[XB_TMO])) break; if (sp > XB_SPIN_CAP) { atomicAdd(&bar[XB_TMO], 1u); break; } }
    }
    nloc = mine > 0u ? mine : 1u; nx = cnt > 0u ? cnt : 1u;
}
__device__ __forceinline__ void xcd_barrier(const XcdBarrier& b) {
    asm volatile("s_waitcnt vmcnt(0)" ::: "memory");
    __syncthreads();
    if (threadIdx.x == 0) {
        unsigned* bar = b.bar;
        __builtin_amdgcn_s_waitcnt(0);
        unsigned nloc = b.st[0], nx = b.st[1];
        if (nloc == 0u) { xcd_barrier_complete(bar, b.x, nloc, nx); b.st[0] = nloc; b.st[1] = nx; }
        const unsigned old = xb_add(&bar[XB_XSUB(b.x)], 1u);
        const unsigned gen = old / nloc;
        if (old + 1u == (gen + 1u) * nloc) {
            __builtin_amdgcn_fence(__ATOMIC_RELEASE, "agent");
            asm volatile("s_waitcnt vmcnt(0)" ::: "memory");
            const unsigned og = xb_add(&bar[XB_TOP], 1u);
            const unsigned tg = og / nx;
            if (og + 1u == (tg + 1u) * nx) xb_add(&bar[XB_TOPGEN], 1u);
            else XB_SPIN(xb_ld(&bar[XB_TOPGEN]) == tg, bar);
            __builtin_amdgcn_fence(__ATOMIC_ACQUIRE, "agent");
            xb_add(&bar[XB_XGEN(b.x)], 1u);
            asm volatile("s_waitcnt vmcnt(0)" ::: "memory");
        } else {
            XB_SPIN(xb_ld(&bar[XB_XGEN(b.x)]) == gen, bar);
            __builtin_amdgcn_fence(__ATOMIC_ACQUIRE, "agent");
            asm volatile("s_waitcnt vmcnt(0)" ::: "memory");
        }
    }
    __syncthreads();
}

namespace pg8 {
#define PG8_LAS __attribute__((address_space(3)))
typedef unsigned short bf16_t;
typedef short bf16x8 __attribute__((ext_vector_type(8)));
typedef float f32x4 __attribute__((ext_vector_type(4)));
typedef unsigned u32x4 __attribute__((ext_vector_type(4)));
constexpr int BM = 256, BK = 64, HALF = 128, HTB = HALF * BK * 2  , STAGE_BYTES = 8 * HTB, NXCD = 8, WGM = 8;

__host__ __device__ __forceinline__ int lds_byte(int r, int c) { const int st = (r >> 4) * 2 + (c >> 5), rr = r & 15, cc = c & 31, ob = rr * 64 + cc * 2; return st * 1024 + (ob ^ (((ob >> 9) & 1) << 5)); }
__host__ __device__ __forceinline__ void stage_rc(int b, int& R, int& C) { const int st = b / 1024, sb = b % 1024, swz = sb ^ (((sb >> 9) & 1) << 5); R = (st >> 1) * 16 + swz / 64; C = (st & 1) * 32 + (swz % 64) / 2; }
__host__ __device__ __forceinline__ int perm32(int rho) { const int n = rho >> 4, i = rho & 15; return 8 * (i >> 2) + 4 * n + (i & 3); }

struct Unit { int pm, pn; };
struct Gemm { const bf16_t* A; const bf16_t* Bt; int M, N, K; };

struct StaticOrder {
    int nM, nN, nwg, G, c;
    __host__ __device__ void init(int M, int N, int G_, int c_) { nM = M / BM; nN = N / BM; nwg = nM * nN; G = G_; c = c_; }
    __host__ __device__ bool next(int i, Unit& u) const {
        const long L = (long)i * G + c; if (L >= nwg) return false;
        int wgid = (int)L; { const int q = nwg / NXCD, r = nwg % NXCD, xcd = wgid % NXCD, off = wgid / NXCD; wgid = (xcd < r ? xcd * (q + 1) : r * (q + 1) + (xcd - r) * q) + off; }
        const int nig = WGM * nN, gid = wgid / nig, fm = gid * WGM, gsz = (nM - fm) < WGM ? (nM - fm) : WGM;
        u.pm = fm + ((wgid % nig) % gsz); u.pn = (wgid % nig) / gsz; return true;
    }
    __device__ __forceinline__ void a_ready(const Unit&) const {}
    __device__ __forceinline__ void done(const Unit&) const {}
};

__device__ __forceinline__ unsigned cvt_pk_bf16(float lo, float hi) { unsigned r; asm volatile("v_cvt_pk_bf16_f32 %0, %1, %2" : "=v"(r) : "v"(lo), "v"(hi)); return r; }
typedef float f32x2 __attribute__((ext_vector_type(2)));
__device__ __forceinline__ f32x2 gelu_pk(f32x2 v) {
    const f32x2 av = __builtin_elementwise_abs(v), d = av * 0.2316418882f + 1.0f;
    f32x2 t; t.x = __builtin_amdgcn_rcpf(d.x); t.y = __builtin_amdgcn_rcpf(d.y);
    f32x2 q = t * 0.5307027145f + (-0.7265760135f); q = q * t + 0.7107068705f; q = q * t + (-0.142248368f); q = q * t + 0.127414796f; q = q * t;
    const f32x2 s = (v * v) * (-0.72134752044f);
    f32x2 e; e.x = __builtin_amdgcn_exp2f(s.x); e.y = __builtin_amdgcn_exp2f(s.y);
    const f32x2 m = v * (q * e), r = v - m;
    f32x2 o; o.x = v.x < 0.f ? m.x : r.x; o.y = v.y < 0.f ? m.y : r.y; return o;
}

template <int ACT  > struct EpiBf16 {
    static constexpr bool PERM = true, AFTER_DRAIN = false; static_assert(ACT == 0 || ACT == 1, "EpiBf16: ACT is 0 (none) or 1 (gelu_pk)");
    bf16_t* O; int ldc; const float* bias; int split_cols; size_t split_stride; float scale0;
    __device__ __forceinline__ void operator()(const f32x4 (&acc)[2][2][4][2], const Unit& u, int wr, int wc, int fr, int fq) const {
        const int row0 = u.pm * BM + wr * 64 + fr; int colt = u.pn * BM; bf16_t* base = O;
        float sc = 1.f; if (split_cols) { const int t = colt / split_cols; base += (size_t)t * split_stride; colt -= t * split_cols; if (t == 0) sc = scale0; }
        const int col0 = colt + wc * 32 + 8 * fq, bcol0 = u.pn * BM + wc * 32 + 8 * fq;
        f32x4 bv[2][2];
#pragma unroll
        for (int bj = 0; bj < 2; ++bj)
#pragma unroll
            for (int n = 0; n < 2; ++n) bv[bj][n] = bias ? *(const f32x4*)(bias + bcol0 + bj * HALF + 4 * n) : (f32x4){0.f, 0.f, 0.f, 0.f};
#pragma unroll
        for (int ai = 0; ai < 2; ++ai)
#pragma unroll
            for (int m = 0; m < 4; ++m) { bf16_t* rowp = base + (size_t)(row0 + ai * HALF + m * 16) * ldc + col0;
#pragma unroll
                for (int bj = 0; bj < 2; ++bj) { f32x4 v0 = acc[ai][bj][m][0] + bv[bj][0], v1 = acc[ai][bj][m][1] + bv[bj][1];
                    if (ACT == 1) { f32x2 a = gelu_pk((f32x2){v0[0], v0[1]}), b = gelu_pk((f32x2){v0[2], v0[3]}), c = gelu_pk((f32x2){v1[0], v1[1]}), d = gelu_pk((f32x2){v1[2], v1[3]});
                        v0 = (f32x4){a.x, a.y, b.x, b.y}; v1 = (f32x4){c.x, c.y, d.x, d.y}; }
                    v0 = v0 * sc; v1 = v1 * sc; u32x4 w; w.x = cvt_pk_bf16(v0[0], v0[1]); w.y = cvt_pk_bf16(v0[2], v0[3]); w.z = cvt_pk_bf16(v1[0], v1[1]); w.w = cvt_pk_bf16(v1[2], v1[3]);
                    *(u32x4*)(rowp + bj * HALF) = w; } }
    }
};
struct EpiResGate {
    static constexpr bool PERM = false, AFTER_DRAIN = false;
    const float* base; float* out; const float* gate; int ldc; int rows_per_b; int gstr;
    __device__ __forceinline__ void operator()(const f32x4 (&acc)[2][2][4][2], const Unit& u, int wr, int wc, int fr, int fq) const {
        const int b = (u.pm * BM) / rows_per_b; const int col0 = u.pn * BM + wc * 32 + 4 * fq;
        f32x4 gv[2][2];
#pragma unroll
        for (int bj = 0; bj < 2; ++bj)
#pragma unroll
            for (int n = 0; n < 2; ++n) gv[bj][n] = *(const f32x4*)(gate + (size_t)b * gstr + col0 + bj * HALF + n * 16);
#pragma unroll
        for (int ai = 0; ai < 2; ++ai)
#pragma unroll
            for (int m = 0; m < 4; ++m) { const size_t off = (size_t)(u.pm * BM + ai * HALF + wr * 64 + m * 16 + fr) * ldc + col0;
#pragma unroll
                for (int bj = 0; bj < 2; ++bj)
#pragma unroll
                    for (int n = 0; n < 2; ++n) { const f32x4 bs = *(const f32x4*)(base + off + bj * HALF + n * 16); *(f32x4*)(out + off + bj * HALF + n * 16) = bs + gv[bj][n] * acc[ai][bj][m][n]; } }
    }
};
struct EpiSwiGLU {
    static constexpr bool PERM = true, AFTER_DRAIN = false;
    bf16_t* O; int ldc;
    __device__ __forceinline__ void operator()(const f32x4 (&acc)[2][2][4][2], const Unit& u, int wr, int wc, int fr, int fq) const {
        const int row0 = u.pm * BM + wr * 64 + fr, col0 = u.pn * HALF + wc * 32 + 8 * fq;
#pragma unroll
        for (int ai = 0; ai < 2; ++ai)
#pragma unroll
            for (int m = 0; m < 4; ++m) { bf16_t* rowp = O + (size_t)(row0 + ai * HALF + m * 16) * ldc + col0; float v[8];
#pragma unroll
                for (int n = 0; n < 2; ++n)
#pragma unroll
                    for (int e = 0; e < 4; ++e) { const float g = acc[ai][0][m][n][e], up = acc[ai][1][m][n][e]; v[4 * n + e] = g * __builtin_amdgcn_rcpf(1.0f + __builtin_amdgcn_exp2f(-1.4426950408889634f * g)) * up; }
                u32x4 w; w.x = cvt_pk_bf16(v[0], v[1]); w.y = cvt_pk_bf16(v[2], v[3]); w.z = cvt_pk_bf16(v[4], v[5]); w.w = cvt_pk_bf16(v[6], v[7]);
                *(u32x4*)rowp = w; }
    }
};
template <class Epi, class Sched, bool ALIGN_EPI = false, bool SP2 = false>
__device__ __forceinline__ void gemm_phase(PG8_LAS unsigned char* lds, const Gemm g, const Sched& S, const Epi& E) {
    const int tid = threadIdx.x, wid = __builtin_amdgcn_readfirstlane(tid >> 6), lane = tid & 63, wr = wid >> 2, wc = wid & 3, fr = lane & 15, fq = lane >> 4;
    const int K = g.K, nt = K / BK;
    unsigned voffA[2], voffB[2];
#pragma unroll
    for (int i = 0; i < 2; ++i) { int R, C; stage_rc(tid * 16 + i * 8192, R, C); const int Rb = Epi::PERM ? ((R & ~31) + perm32(R & 31)) : R;
        voffA[i] = (unsigned)(R * K + C) * 2u; voffB[i] = (unsigned)(Rb * K + C) * 2u; }
    const size_t kstep = (size_t)(BK * 2);
    const size_t hstep = (size_t)HALF * K * 2;
    const size_t tstep = 2 * hstep;
    const unsigned ldsw = (unsigned)wid * 1024u;
    const int aoff = lds_byte(wr * 64 + fr, fq * 8), boff = lds_byte(wc * 32 + fr, fq * 8);
#define PG8_SA(b, h) (((b) * 2 + (h)) * HTB)
#define PG8_SB(b, h) ((4 + (b) * 2 + (h)) * HTB)
#define PG8_STAGE(bufoff, gbase, voff) do { _Pragma("unroll") for (int _i = 0; _i < 2; ++_i) \
        __builtin_amdgcn_global_load_lds((const unsigned*)((const char*)(gbase) + (voff)[_i]), (PG8_LAS unsigned*)(lds + (bufoff) + ldsw + _i * 8192), 16, 0, 0); } while (0)
#define PG8_LDA(dst, b, h) do { _Pragma("unroll") for (int m = 0; m < 4; ++m) _Pragma("unroll") for (int k = 0; k < 2; ++k) dst[m][k] = *(const PG8_LAS bf16x8*)(lds + PG8_SA(b, h) + aoff + m * 2048 + k * 1024); } while (0)
#define PG8_LDB(dst, b, h) do { _Pragma("unroll") for (int n = 0; n < 2; ++n) _Pragma("unroll") for (int k = 0; k < 2; ++k) dst[n][k] = *(const PG8_LAS bf16x8*)(lds + PG8_SB(b, h) + boff + n * 2048 + k * 1024); } while (0)
#define PG8_MMA(ai, bj, At, Bt) do { __builtin_amdgcn_s_setprio(1); _Pragma("unroll") for (int m = 0; m < 4; ++m) _Pragma("unroll") for (int n = 0; n < 2; ++n) _Pragma("unroll") for (int k = 0; k < 2; ++k) \
        acc[ai][bj][m][n] = __builtin_amdgcn_mfma_f32_16x16x32_bf16(Bt[n][k], At[m][k], acc[ai][bj][m][n], 0, 0, 0); __builtin_amdgcn_s_setprio(0); } while (0)
#define PG8_WAIT_V(n) asm volatile("s_waitcnt vmcnt(" #n ")" ::: "memory")
#define PG8_WAIT_L(n) asm volatile("s_waitcnt lgkmcnt(" #n ")" ::: "memory")
#define PG8_BAR __builtin_amdgcn_s_barrier()
#define PG8_SCHED __builtin_amdgcn_sched_barrier(0)
    Unit cur, nxt; int ui = 0;
    if (!S.next(0, cur)) return;
    f32x4 acc[2][2][4][2];
#pragma unroll
    for (int a = 0; a < 2; ++a)
#pragma unroll
        for (int b = 0; b < 2; ++b)
#pragma unroll
            for (int m = 0; m < 4; ++m)
#pragma unroll
                for (int n = 0; n < 2; ++n) acc[a][b][m][n] = (f32x4){0.f, 0.f, 0.f, 0.f};
    bf16x8 At[4][2], B0[2][2], B1[2][2];
    const char* cA = (const char*)g.A + (size_t)cur.pm * tstep; const char* cB = (const char*)g.Bt + (size_t)cur.pn * tstep;
    S.a_ready(cur);
    if constexpr (SP2) {
        PG8_STAGE(PG8_SB(0, 0), cB, voffB); PG8_STAGE(PG8_SB(0, 1), cB + hstep, voffB); PG8_STAGE(PG8_SA(0, 0), cA, voffA); PG8_STAGE(PG8_SA(0, 1), cA + hstep, voffA);
        if (wr == 1) PG8_BAR;
        PG8_WAIT_V(2); PG8_BAR;
        PG8_STAGE(PG8_SB(1, 0), cB + kstep, voffB); PG8_STAGE(PG8_SA(1, 0), cA + kstep, voffA); PG8_STAGE(PG8_SB(1, 1), cB + hstep + kstep, voffB);
        PG8_WAIT_V(6); PG8_BAR;
    } else {
        PG8_STAGE(PG8_SB(0, 0), cB, voffB); PG8_STAGE(PG8_SA(0, 0), cA, voffA); PG8_STAGE(PG8_SB(0, 1), cB + hstep, voffB); PG8_STAGE(PG8_SA(0, 1), cA + hstep, voffA);
        if (wr == 1) PG8_BAR;
        PG8_WAIT_V(4); PG8_BAR;
        PG8_STAGE(PG8_SB(1, 0), cB + kstep, voffB); PG8_STAGE(PG8_SA(1, 0), cA + kstep, voffA); PG8_STAGE(PG8_SB(1, 1), cB + hstep + kstep, voffB);
        PG8_WAIT_V(6); PG8_BAR;
    }
    for (;;) {
        const bool has_next = S.next(ui + 1, nxt);
        const char* nA = has_next ? (const char*)g.A + (size_t)nxt.pm * tstep : cA; const char* nB = has_next ? (const char*)g.Bt + (size_t)nxt.pn * tstep : cB;
        for (int t = 0; t < nt; t += 2) {
            const bool last = (t == nt - 2);
            const char* a1 = cA + (size_t)(t + 1) * kstep;
            const char* a2 = last ? nA : cA + (size_t)(t + 2) * kstep; const char* b2 = last ? nB : cB + (size_t)(t + 2) * kstep;
            const char* a3 = a2 + kstep; const char* b3 = b2 + kstep;
            if (last && has_next) S.a_ready(nxt);
            if constexpr (SP2) {
            PG8_LDB(B0, 0, 0); PG8_LDB(B1, 0, 1); PG8_SCHED; PG8_LDA(At, 0, 0); PG8_STAGE(PG8_SA(1, 1), a1 + hstep, voffA);
            PG8_WAIT_V(8); PG8_WAIT_L(0); PG8_BAR; PG8_MMA(0, 0, At, B0); PG8_MMA(0, 1, At, B1); PG8_BAR; PG8_SCHED;
            PG8_LDA(At, 0, 1); PG8_STAGE(PG8_SB(0, 0), b2, voffB); PG8_STAGE(PG8_SB(0, 1), b2 + hstep, voffB); PG8_STAGE(PG8_SA(0, 0), a2, voffA);
            PG8_WAIT_V(8); PG8_WAIT_L(0); PG8_BAR; PG8_MMA(1, 0, At, B0); PG8_MMA(1, 1, At, B1); PG8_BAR; PG8_SCHED;
            PG8_LDB(B0, 1, 0); PG8_LDB(B1, 1, 1); PG8_SCHED; PG8_LDA(At, 1, 0); PG8_STAGE(PG8_SA(0, 1), a2 + hstep, voffA);
            PG8_WAIT_V(8); PG8_WAIT_L(0); PG8_BAR; PG8_MMA(0, 0, At, B0); PG8_MMA(0, 1, At, B1); PG8_BAR; PG8_SCHED;
            PG8_LDA(At, 1, 1); PG8_STAGE(PG8_SB(1, 0), b3, voffB); PG8_STAGE(PG8_SB(1, 1), b3 + hstep, voffB); PG8_STAGE(PG8_SA(1, 0), a3, voffA);
            PG8_WAIT_V(8); PG8_WAIT_L(0); PG8_BAR; PG8_MMA(1, 0, At, B0); PG8_MMA(1, 1, At, B1); PG8_BAR; PG8_SCHED;
            } else {
            PG8_LDB(B0, 0, 0); PG8_SCHED; PG8_LDA(At, 0, 0); PG8_STAGE(PG8_SA(1, 1), a1 + hstep, voffA);
            PG8_WAIT_L(8); PG8_BAR; PG8_WAIT_L(0); PG8_MMA(0, 0, At, B0); PG8_BAR; PG8_SCHED;
            PG8_LDB(B1, 0, 1); PG8_STAGE(PG8_SB(0, 0), b2, voffB);
            PG8_BAR; PG8_WAIT_L(0); PG8_MMA(0, 1, At, B1); PG8_BAR;
            PG8_LDA(At, 0, 1); PG8_STAGE(PG8_SA(0, 0), a2, voffA);
            PG8_BAR; PG8_WAIT_L(0); PG8_MMA(1, 0, At, B0); PG8_BAR; PG8_SCHED;
            PG8_STAGE(PG8_SB(0, 1), b2 + hstep, voffB);
            PG8_WAIT_V(6); PG8_BAR; PG8_MMA(1, 1, At, B1); PG8_BAR;
            PG8_LDB(B0, 1, 0); PG8_SCHED; PG8_LDA(At, 1, 0); PG8_STAGE(PG8_SA(0, 1), a2 + hstep, voffA);
            PG8_WAIT_L(8); PG8_BAR; PG8_WAIT_L(0); PG8_MMA(0, 0, At, B0); PG8_BAR; PG8_SCHED;
            PG8_LDB(B1, 1, 1); PG8_STAGE(PG8_SB(1, 0), b3, voffB);
            PG8_BAR; PG8_WAIT_L(0); PG8_MMA(0, 1, At, B1); PG8_BAR;
            PG8_LDA(At, 1, 1); PG8_STAGE(PG8_SA(1, 0), a3, voffA);
            PG8_BAR; PG8_WAIT_L(0); PG8_MMA(1, 0, At, B0); PG8_BAR; PG8_SCHED;
            PG8_STAGE(PG8_SB(1, 1), b3 + hstep, voffB);
            PG8_WAIT_V(6); PG8_BAR; PG8_MMA(1, 1, At, B1); PG8_BAR;
            }
        }
        if constexpr (ALIGN_EPI) { if (wr == 0) PG8_BAR; }
        if constexpr (!Epi::AFTER_DRAIN) { E(acc, cur, wr, wc, fr, fq); S.done(cur); }
        if (!has_next) break;
#pragma unroll
        for (int a = 0; a < 2; ++a)
#pragma unroll
            for (int b = 0; b < 2; ++b)
#pragma unroll
                for (int m = 0; m < 4; ++m)
#pragma unroll
                    for (int n = 0; n < 2; ++n) acc[a][b][m][n] = (f32x4){0.f, 0.f, 0.f, 0.f};
        cur = nxt; cA = nA; cB = nB; ++ui;
        if constexpr (ALIGN_EPI) { if (wr == 1) PG8_BAR; }
    }
    PG8_WAIT_V(0);
    if constexpr (!ALIGN_EPI) { if (wr == 0) PG8_BAR; }
    PG8_BAR;
    if constexpr (Epi::AFTER_DRAIN) { E.fused(acc, cur, wr, wc, fr, fq, lds, wid, lane); S.done(cur); }
#undef PG8_SA
#undef PG8_SB
#undef PG8_STAGE
#undef PG8_LDA
#undef PG8_LDB
#undef PG8_MMA
#undef PG8_WAIT_V
#undef PG8_WAIT_L
#undef PG8_BAR
#undef PG8_SCHED
}
}

#ifndef PG8_SP2
#define PG8_SP2 true
#endif
#ifndef PG8_ALIGN
#define PG8_ALIGN true
#endif

struct Frame {
    LAS unsigned char* lds;
    int tid, lane, wave, G, vcu;
    const float *x, *c, *w_ada, *b_ada, *norm1_w, *w_in, *lb_logits, *gnorm_w, *lq1, *lk1, *lq2, *lk2, *subln_w, *w_out, *norm2_w, *w_gate, *w_up, *w_down, *final_w;
    float* out; unsigned char* ws;
    float* MOD; bf16 *WIN, *WOUT, *WGU, *WDN, *U, *MIX, *PROJ, *ACT;
};

__device__ __forceinline__ void p0_transpose_item(const float* W, int K, int N, bf16* WT, int gstride, int goff, LAS float* scr, int item, int lane) {
    const int nblk = N / 32, kb = item / nblk, nb = item % nblk, k0 = 64 * kb, n0 = 32 * nb;
#pragma unroll 8
    for (int i = 0; i < 32; ++i) { const int kk = 2 * i + (lane >> 5); scr[kk * 33 + (lane & 31)] = W[(size_t)(k0 + kk) * N + n0 + (lane & 31)]; }
    LDS_WAIT(); asm volatile("" ::: "memory");
    const int c = lane & 7;
    const int rbase = (n0 / 128) * gstride + (n0 % 128) + goff;
#pragma unroll
    for (int j = 0; j < 4; ++j) { const int n = (lane >> 3) + 8 * j; const LAS float* s = scr + (8 * c) * 33 + n;
        v4u o; o.x = pk2(s[0 * 33], s[1 * 33]); o.y = pk2(s[2 * 33], s[3 * 33]); o.z = pk2(s[4 * 33], s[5 * 33]); o.w = pk2(s[6 * 33], s[7 * 33]);
        *(GAS v4u*)(WT + (size_t)(rbase + n) * K + k0 + 8 * c) = o; }
    LDS_WAIT(); asm volatile("" ::: "memory");
}
__device__ __forceinline__ void phase_wconv(Frame& F) {
    LAS float* scr = (LAS float*)(F.lds + F.wave * 16384);
    const int gw = F.vcu * NWAVES + F.wave, NGW = F.G * NWAVES;
    constexpr int I_IN = (DM / 64) * (NIN / 32), I_OUT = (DM / 64) * (DM / 32), I_G = (DM / 64) * (DFF / 32), I_DN = (DFF / 64) * (DM / 32);
    constexpr int NITEMS = I_IN + I_OUT + 2 * I_G + I_DN;
    for (int it = gw; it < NITEMS; it += NGW) {
        int r = it;
        if (r < I_IN) { p0_transpose_item(F.w_in, DM, NIN, F.WIN, 128, 0, scr, r, F.lane); continue; } r -= I_IN;
        if (r < I_OUT) { p0_transpose_item(F.w_out, DM, DM, F.WOUT, 128, 0, scr, r, F.lane); continue; } r -= I_OUT;
        if (r < I_G) { p0_transpose_item(F.w_gate, DM, DFF, F.WGU, 256, 0, scr, r, F.lane); continue; } r -= I_G;
        if (r < I_G) { p0_transpose_item(F.w_up, DM, DFF, F.WGU, 256, 128, scr, r, F.lane); continue; } r -= I_G;
        p0_transpose_item(F.w_down, DFF, DM, F.WDN, 128, 0, scr, r, F.lane);
    }
}
__device__ __forceinline__ void phase_mod(Frame& F) {
    LAS float* red = (LAS float*)F.lds;
    LAS float* sil = (LAS float*)(F.lds + AUX_OFF) + F.wave * 256;
    for (int it = F.vcu; it < 24 * 8; it += F.G) {
        const int cg = it % 24, s = it / 24, k0 = s * 128 + F.wave * 16;
#pragma unroll
        for (int j = 0; j < 4; ++j) { const int e = F.lane * 4 + j, kk = e >> 4, b = e & 15; sil[kk * 16 + b] = siluf_(F.c[b * DM + k0 + kk]); }
        LDS_WAIT(); asm volatile("" ::: "memory");
        f32x4 acc[16];
#pragma unroll
        for (int b = 0; b < 16; ++b) acc[b] = (f32x4){0.f, 0.f, 0.f, 0.f};
        const GAS f32x4* wp = (const GAS f32x4*)(F.w_ada + (size_t)k0 * NMOD + cg * 256) + F.lane;
#pragma unroll 4
        for (int kk = 0; kk < 16; ++kk) { const f32x4 w = wp[(size_t)kk * (NMOD / 4)];
#pragma unroll
            for (int b = 0; b < 16; ++b) { const float sv = sil[kk * 16 + b]; acc[b] += w * sv; } }
#pragma unroll
        for (int b = 0; b < 16; ++b) *(LAS f32x4*)(red + (F.wave * 16 + b) * 256 + F.lane * 4) = acc[b];
        __syncthreads();
#pragma unroll
        for (int o = 0; o < 8; ++o) { const int idx = F.tid + NTHR * o, b = idx >> 8, col = idx & 255; float sum = 0.f;
#pragma unroll
            for (int w = 0; w < 8; ++w) sum += red[(w * 16 + b) * 256 + col];
            if (s == 0) sum += F.b_ada[cg * 256 + col];
            atomicAdd(F.MOD + b * NMOD + cg * 256 + col, sum); }
        __syncthreads();
    }
}
__device__ __forceinline__ void phase_modnorm(Frame& F, const float* src, const float* nw, int sh_off, int sc_off) {
    const int gw = F.vcu * NWAVES + F.wave, NGW = F.G * NWAVES;
    constexpr int RPW = 16;
    for (int blk = gw; blk < M / RPW; blk += NGW) {
        const int m0 = blk * RPW, b = m0 / SEQ;
        f32x4 a[4], sh[4];
#pragma unroll
        for (int j = 0; j < 4; ++j) { const int col = 256 * j + 4 * F.lane;
            const f32x4 w = *(const GAS f32x4*)(nw + col), sc = *(const GAS f32x4*)(F.MOD + b * NMOD + sc_off + col);
            sh[j] = *(const GAS f32x4*)(F.MOD + b * NMOD + sh_off + col); a[j] = w * (sc + 1.0f); }
        for (int r = 0; r < RPW; ++r) {
            const GAS f32x4* xr = (const GAS f32x4*)(src + (size_t)(m0 + r) * DM) + F.lane;
            f32x4 v[4]; float s = 0.f;
#pragma unroll
            for (int j = 0; j < 4; ++j) { v[j] = xr[64 * j]; s += (v[j].x * v[j].x + v[j].y * v[j].y) + (v[j].z * v[j].z + v[j].w * v[j].w); }
            const float rstd = 1.0f / sqrtf(wave_sum(s) * (1.0f / DM) + EPS);
            GAS v2u* o8 = (GAS v2u*)(F.U + (size_t)(m0 + r) * DM) + F.lane;
#pragma unroll
            for (int j = 0; j < 4; ++j) { const f32x4 y = v[j] * rstd * a[j] + sh[j]; v2u w; w.x = pk2(y.x, y.y); w.y = pk2(y.z, y.w); o8[64 * j] = w; }
        }
    }
}
__device__ __forceinline__ void phase_final_norm(Frame& F, float oscale) {
    const int gw = F.vcu * NWAVES + F.wave, NGW = F.G * NWAVES;
    f32x4 w[4];
#pragma unroll
    for (int j = 0; j < 4; ++j) w[j] = *(const GAS f32x4*)(F.final_w + 256 * j + 4 * F.lane);
    for (int m = gw; m < M; m += NGW) {
        GAS f32x4* xr = (GAS f32x4*)(F.out + (size_t)m * DM) + F.lane;
        f32x4 v[4]; float s = 0.f;
#pragma unroll
        for (int j = 0; j < 4; ++j) { v[j] = xr[64 * j]; s += (v[j].x * v[j].x + v[j].y * v[j].y) + (v[j].z * v[j].z + v[j].w * v[j].w); }
        const float rstd = 1.0f / sqrtf(wave_sum(s) * (1.0f / DM) + EPS);
#pragma unroll
        for (int j = 0; j < 4; ++j) xr[64 * j] = v[j] * (rstd * oscale) * w[j];
    }
}
template <class Epi>
__device__ __forceinline__ void gemm_simple(Frame& F, const bf16* A, const bf16* Bt, int Mr, int N, int K, const Epi& E) {
    const int gw = F.vcu * NWAVES + F.wave, NGW = F.G * NWAVES;
    const int r16 = F.lane & 15, q = F.lane >> 4;
    const int ntn = N / 64, ntiles = (Mr / 64) * ntn;
    for (int t = gw; t < ntiles; t += NGW) {
        const int tm = t / ntn, tn = t % ntn;
        f32x4 acc[4][4];
#pragma unroll
        for (int i = 0; i < 4; ++i)
#pragma unroll
            for (int j = 0; j < 4; ++j) acc[i][j] = (f32x4){0.f, 0.f, 0.f, 0.f};
        const bf16* ap = A + (size_t)(tm * 64 + r16) * K + q * 8;
        const bf16* bp = Bt + (size_t)(tn * 64 + r16) * K + q * 8;
        for (int k0 = 0; k0 < K; k0 += 32) {
            bf16x8 a[4], b[4];
#pragma unroll
            for (int i = 0; i < 4; ++i) { a[i] = *(const GAS bf16x8*)(ap + (size_t)i * 16 * K + k0); b[i] = *(const GAS bf16x8*)(bp + (size_t)i * 16 * K + k0); }
#pragma unroll
            for (int i = 0; i < 4; ++i)
#pragma unroll
                for (int j = 0; j < 4; ++j) acc[i][j] = __builtin_amdgcn_mfma_f32_16x16x32_bf16(a[i], b[j], acc[i][j], 0, 0, 0);
        }
#pragma unroll
        for (int i = 0; i < 4; ++i)
#pragma unroll
            for (int j = 0; j < 4; ++j)
#pragma unroll
                for (int e = 0; e < 4; ++e) E(tm * 64 + i * 16 + q * 4 + e, tn * 64 + j * 16 + r16, acc[i][j][e]);
    }
}
struct EpiProjS { bf16* O; __device__ __forceinline__ void operator()(int r, int c, float v) const { O[(size_t)r * NIN + c] = (bf16)f2bf(v); } };
struct EpiResS { const float* base; const float* gate; float* O;
    __device__ __forceinline__ void operator()(int r, int c, float v) const { const int b = r / SEQ; O[(size_t)r * DM + c] = base[(size_t)r * DM + c] + gate[b * NMOD + c] * v; } };

__device__ __forceinline__ void phase_hgrn_naive(Frame& F, bf16* MIXD) {
    LAS float* qs = (LAS float*)F.lds;
    LAS float* fs = qs + 128;
    LAS float* red = fs + 128;
    float* OR = (float*)(F.ws + WS_SST);
    const int v = F.tid & 127, ks = F.tid >> 7;
    for (int it = F.vcu; it < BATCH * 4; it += F.G) {
        const int b = it >> 2, h = it & 3;
        const float a0 = F.lb_logits[h * 128 + v], a1 = F.lb_logits[512 + h * 128 + v];
        const float lb = 1.0f / (1.0f + __expf(a1 - a0));
        float S[32];
#pragma unroll
        for (int i = 0; i < 32; ++i) S[i] = 0.f;
        for (int t = 0; t < SEQ; ++t) {
            const size_t row = (size_t)(b * SEQ + t) * NIN;
            const float iv = bf2f(F.PROJ[row + OFF_HI + h * 128 + v]);
            if (ks == 0) { const float qv = bf2f(F.PROJ[row + OFF_HQ + h * 128 + v]), fl = bf2f(F.PROJ[row + OFF_HF + h * 128 + v]);
                qs[v] = qv; fs[v] = lb + (1.0f - lb) * sigmoidf_(fl); }
            __syncthreads();
            float part = 0.f;
#pragma unroll
            for (int i = 0; i < 32; ++i) { const float f = fs[ks * 32 + i], qv = qs[ks * 32 + i]; S[i] = f * S[i] + (1.0f - f) * iv; part += qv * S[i]; }
            red[ks * 128 + v] = part;
            __syncthreads();
            if (ks == 0) OR[(size_t)(b * SEQ + t) * 512 + h * 128 + v] = (red[v] + red[128 + v]) + (red[256 + v] + red[384 + v]);
        }
        VM_WAIT(); __syncthreads();
        const float gw0 = F.gnorm_w[2 * F.lane], gw1 = F.gnorm_w[2 * F.lane + 1];
        for (int t = F.wave; t < SEQ; t += NWAVES) {
            const size_t m = (size_t)(b * SEQ + t);
            const f32x2 o = *(const GAS f32x2*)(OR + m * 512 + h * 128 + 2 * F.lane);
            const float rstd = 1.0f / sqrtf(wave_sum(o.x * o.x + o.y * o.y) * (1.0f / 128.0f) + EPS);
            const unsigned gg = *(const GAS unsigned*)(F.PROJ + m * NIN + OFF_HG + h * 128 + 2 * F.lane);
            *(GAS unsigned*)(MIXD + m * DM + h * 128 + 2 * F.lane) = pk2(o.x * rstd * gw0 * siluf_(bflo(gg)), o.y * rstd * gw1 * siluf_(bfhi(gg)));
        }
        __syncthreads();
    }
}
__device__ __forceinline__ float diff_lambda(const Frame& F) {
    float s1 = 0.f, s2 = 0.f;
    for (int i = 0; i < 64; ++i) { s1 += F.lq1[i] * F.lk1[i]; s2 += F.lq2[i] * F.lk2[i]; }
    return __expf(s1) - __expf(s2) + LAMBDA_INIT;
}
__device__ __forceinline__ void phase_attn_naive(Frame& F, bf16* MIXD) {
    LAS float* qf = (LAS float*)F.lds;
    LAS float* wbuf = qf + 128;
    LAS float* pbuf = wbuf + 2048;
    LAS float* redm = pbuf + 2048;
    LAS float* part = redm + 64;
    const float lam = diff_lambda(F);
    for (int it = F.vcu; it < M * 4; it += F.G) {
        const int h = it & 3, m = it >> 2, b = m / SEQ, t = m % SEQ;
        const float slope = exp2f(-2.0f * (h + 1));
        if (F.tid < 128) qf[F.tid] = bf2f(F.PROJ[(size_t)m * NIN + OFF_AQ + h * 128 + F.tid]) * 0.125f;
        __syncthreads();
        float s1[4], s2[4]; float m1 = -INFINITY, m2 = -INFINITY;
#pragma unroll
        for (int j = 0; j < 4; ++j) { const int s = F.tid + NTHR * j; s1[j] = -INFINITY; s2[j] = -INFINITY;
            if (s <= t) { const bf16* kp = F.PROJ + (size_t)(b * SEQ + s) * NIN + OFF_AK + h * 128; float d1 = 0.f, d2 = 0.f;
#pragma unroll
                for (int i = 0; i < 8; ++i) { const v4u w1 = *(const GAS v4u*)(kp + 8 * i), w2 = *(const GAS v4u*)(kp + 64 + 8 * i);
                    d1 += bflo(w1.x) * qf[8 * i] + bfhi(w1.x) * qf[8 * i + 1] + bflo(w1.y) * qf[8 * i + 2] + bfhi(w1.y) * qf[8 * i + 3] + bflo(w1.z) * qf[8 * i + 4] + bfhi(w1.z) * qf[8 * i + 5] + bflo(w1.w) * qf[8 * i + 6] + bfhi(w1.w) * qf[8 * i + 7];
                    d2 += bflo(w2.x) * qf[64 + 8 * i] + bfhi(w2.x) * qf[64 + 8 * i + 1] + bflo(w2.y) * qf[64 + 8 * i + 2] + bfhi(w2.y) * qf[64 + 8 * i + 3] + bflo(w2.z) * qf[64 + 8 * i + 4] + bfhi(w2.z) * qf[64 + 8 * i + 5] + bflo(w2.w) * qf[64 + 8 * i + 6] + bfhi(w2.w) * qf[64 + 8 * i + 7]; }
                const float bias = slope * (float)(t - s); s1[j] = d1 - bias; s2[j] = d2 - bias; m1 = fmaxf(m1, s1[j]); m2 = fmaxf(m2, s2[j]); } }
        m1 = wave_max(m1); m2 = wave_max(m2);
        if (F.lane == 0) { redm[F.wave] = m1; redm[8 + F.wave] = m2; }
        __syncthreads();
        m1 = redm[0]; m2 = redm[8];
#pragma unroll
        for (int w = 1; w < 8; ++w) { m1 = fmaxf(m1, redm[w]); m2 = fmaxf(m2, redm[8 + w]); }
        float l1 = 0.f, l2 = 0.f;
#pragma unroll
        for (int j = 0; j < 4; ++j) { const int s = F.tid + NTHR * j; if (s <= t) { const float p1 = __expf(s1[j] - m1), p2 = __expf(s2[j] - m2); l1 += p1; l2 += p2; wbuf[s] = p1; pbuf[s] = p2; } }
        l1 = wave_sum(l1); l2 = wave_sum(l2);
        if (F.lane == 0) { redm[16 + F.wave] = l1; redm[24 + F.wave] = l2; }
        __syncthreads();
        l1 = 0.f; l2 = 0.f;
#pragma unroll
        for (int w = 0; w < 8; ++w) { l1 += redm[16 + w]; l2 += redm[24 + w]; }
        const float i1 = 1.0f / l1, i2 = lam / l2;
        const int v = F.tid & 127, sp = F.tid >> 7; float acc = 0.f;
        const bf16* vp = F.PROJ + (size_t)(b * SEQ) * NIN + OFF_AV + h * 128 + v;
        for (int s = sp; s <= t; s += 4) acc += (wbuf[s] * i1 - pbuf[s] * i2) * bf2f(vp[(size_t)s * NIN]);
        part[sp * 128 + v] = acc;
        __syncthreads();
        if (F.tid < 128) { const float o = (part[v] + part[128 + v]) + (part[256 + v] + part[384 + v]);
            float ss = wave_sum(o * o); if (F.lane == 0) redm[32 + F.wave] = ss;
            qf[v] = o; }
        __syncthreads();
        if (F.tid < 128) { const float ss = redm[32] + redm[33]; const float rstd = 1.0f / sqrtf(ss * (1.0f / 128.0f) + EPS);
            MIXD[(size_t)m * DM + 512 + h * 128 + v] = (bf16)f2bf(qf[v] * rstd * F.subln_w[v] * (1.0f - LAMBDA_INIT)); }
        __syncthreads();
    }
}
typedef float f32x16 __attribute__((ext_vector_type(16)));
typedef short s16x4 __attribute__((ext_vector_type(4)));
typedef __bf16 bf16x2_t __attribute__((ext_vector_type(2)));
__device__ __forceinline__ unsigned off_b(unsigned row, unsigned ch) { return 256u * row + 16u * (ch ^ (((row & 3) << 2) | ((row >> 2) & 3))); }
__device__ __forceinline__ unsigned row_rd(unsigned lane, unsigned rb, unsigned s) { return off_b((lane & 31) + 32 * rb, 2 * s + (lane >> 5)); }
__device__ __forceinline__ unsigned tr_rd(unsigned lane, unsigned c, unsigned ks, unsigned t) {
    const unsigned h = lane >> 5, blk = (lane >> 4) & 1, q = (lane & 15) >> 2, p = lane & 3;
    return off_b(16 * ks + 8 * h + 4 * t + q, 4 * c + 2 * blk + (p >> 1)) + 8 * (p & 1);
}
__device__ __forceinline__ unsigned tr_rd_perm(unsigned lane, unsigned c, unsigned ks, unsigned t) {
    const unsigned h = lane >> 5, blk = (lane >> 4) & 1, q = (lane & 15) >> 2, p = lane & 3;
    return off_b(16 * ks + 8 * t + 4 * h + q, 4 * c + 2 * blk + (p >> 1)) + 8 * (p & 1);
}
__device__ __forceinline__ s16x4 vtr(LAS unsigned char* p) { return __builtin_bit_cast(s16x4, __builtin_amdgcn_ds_read_tr16_b64_v4i16((LAS s16x4*)p)); }
__device__ __forceinline__ bf16x8 trfrag(LAS unsigned char* img, unsigned a0, unsigned a1) { const s16x4 lo = vtr(img + a0), hi = vtr(img + a1); return (bf16x8){lo[0], lo[1], lo[2], lo[3], hi[0], hi[1], hi[2], hi[3]}; }
__device__ __forceinline__ unsigned cvtpk(float lo, float hi) { f32x2 v = {lo, hi}; bf16x2_t b = __builtin_convertvector(v, bf16x2_t); return __builtin_bit_cast(unsigned, b); }
__device__ __forceinline__ bf16x8 pack8(const f32x16& x, int b) { v4u w; w.x = cvtpk(x[b], x[b + 1]); w.y = cvtpk(x[b + 2], x[b + 3]); w.z = cvtpk(x[b + 4], x[b + 5]); w.w = cvtpk(x[b + 6], x[b + 7]); return __builtin_bit_cast(bf16x8, w); }
__device__ __forceinline__ int crow(int r, int hi) { return (r & 3) + 8 * (r >> 2) + 4 * hi; }
#define MFMA32(a, b, c) __builtin_amdgcn_mfma_f32_32x32x16_bf16((a), (b), (c), 0, 0, 0)

constexpr int HG_PITCH = 272;
__device__ __forceinline__ void phase_hgrn1(Frame& F) {
    LAS unsigned char* QX = F.lds; LAS unsigned char* KX = F.lds + 16384; LAS unsigned char* VI = F.lds + 32768;
    LAS unsigned char* OS = F.lds;
    LAS unsigned char* UTS = F.lds + 64 * HG_PITCH;
    LAS float* segtot = (LAS float*)(F.lds + 53248);
    LAS float* lmv = (LAS float*)(F.lds + 57344);
    float* DV = (float*)(F.ws + WS_DVEC); bf16* UST = (bf16*)(F.ws + WS_UST);
    const int kp = F.lane, seg = F.wave, r32 = F.lane & 31, hi = F.lane >> 5;
    for (int it = F.vcu; it < BATCH * 4 * 32; it += F.G) {
        const int bh = it >> 5, c = it & 31, b = bh >> 2, h = bh & 3; const size_t R0 = (size_t)b * SEQ + 64 * c;
        const float a00 = F.lb_logits[h * 128 + 2 * kp], a01 = F.lb_logits[h * 128 + 2 * kp + 1], a10 = F.lb_logits[512 + h * 128 + 2 * kp], a11 = F.lb_logits[512 + h * 128 + 2 * kp + 1];
        const float lb0 = 1.0f / (1.0f + __expf(a10 - a00)), lb1 = 1.0f / (1.0f + __expf(a11 - a01));
        bf16* rowp = F.PROJ + (R0 + 8 * seg) * NIN + 128 * h + 2 * kp;
        unsigned fw[8], qw[8];
#pragma unroll
        for (int i = 0; i < 8; ++i) { fw[i] = *(const GAS unsigned*)(rowp + (size_t)i * NIN + OFF_HF); qw[i] = *(const GAS unsigned*)(rowp + (size_t)i * NIN + OFF_HQ); }
        v4u vv[2];
#pragma unroll
        for (int i = 0; i < 2; ++i) { const int n = F.tid + NTHR * i, row = n >> 4, ch = n & 15; vv[i] = *(const GAS v4u*)(F.PROJ + (R0 + row) * NIN + OFF_HI + 128 * h + 8 * ch); }
        float f0[8], f1[8], b0[8], b1[8]; float run0 = 0.f, run1 = 0.f;
#pragma unroll
        for (int i = 0; i < 8; ++i) { f0[i] = lb0 + (1.0f - lb0) * sigmoidf_(bflo(fw[i])); f1[i] = lb1 + (1.0f - lb1) * sigmoidf_(bfhi(fw[i]));
            run0 += __logf(f0[i]); run1 += __logf(f1[i]); b0[i] = run0; b1[i] = run1; }
        *(LAS f32x2*)(segtot + seg * 128 + 2 * kp) = (f32x2){run0, run1};
#pragma unroll
        for (int i = 0; i < 2; ++i) { const int n = F.tid + NTHR * i, row = n >> 4, ch = n & 15; *(LAS v4u*)(VI + off_b(row, ch)) = vv[i]; }
        __syncthreads();
        float of0 = 0.f, of1 = 0.f, md0 = 0.f, md1 = 0.f, la0 = 0.f, la1 = 0.f;
#pragma unroll
        for (int s = 0; s < 8; ++s) { const f32x2 t = *(const LAS f32x2*)(segtot + s * 128 + 2 * kp); if (s < seg) { of0 += t.x; of1 += t.y; } if (s < 4) { md0 += t.x; md1 += t.y; } la0 += t.x; la1 += t.y; }
        const float em0 = __expf(md0), em1 = __expf(md1);
#pragma unroll
        for (int i = 0; i < 8; ++i) { const float bb0 = of0 + b0[i], bb1 = of1 + b1[i];
            const float e0 = __expf(bb0 - md0), e1 = __expf(bb1 - md1), i0 = __expf(md0 - bb0), i1 = __expf(md1 - bb1);
            const float q0 = bflo(qw[i]), q1 = bfhi(qw[i]);
            const unsigned o = off_b(8 * seg + i, kp >> 2) + (kp & 3) * 4;
            *(LAS unsigned*)(QX + o) = pk2(q0 * e0, q1 * e1);
            *(LAS unsigned*)(KX + o) = pk2((1.0f - f0[i]) * i0, (1.0f - f1[i]) * i1);
            *(GAS unsigned*)(rowp + (size_t)i * NIN + OFF_HQ) = pk2(q0 * e0 * em0, q1 * e1 * em1); }
        if (seg == 0) { *(LAS f32x2*)(lmv + 2 * kp) = (f32x2){__expf(la0 - md0), __expf(la1 - md1)}; *(GAS f32x2*)(DV + (size_t)it * 128 + 2 * kp) = (f32x2){__expf(la0), __expf(la1)}; }
        __syncthreads();
        f32x16 acc[4];
#pragma unroll
        for (int i = 0; i < 4; ++i) acc[i] = f32x16{};
        if (F.wave < 4) {
            const int tb = F.wave & 1, vh = F.wave >> 1;
            for (int sb = 0; sb <= tb; ++sb) {
                f32x16 X = f32x16{};
#pragma unroll
                for (int s = 0; s < 8; ++s) { const bf16x8 a = *(const LAS bf16x8*)(KX + row_rd(F.lane, sb, s)), bq = *(const LAS bf16x8*)(QX + row_rd(F.lane, tb, s)); X = MFMA32(a, bq, X); }
                if (sb == tb) {
#pragma unroll
                    for (int r = 0; r < 16; ++r) if (crow(r, hi) > r32) X[r] = 0.f; }
                const bf16x8 xf0 = pack8(X, 0), xf1 = pack8(X, 8);
#pragma unroll
                for (int vi = 0; vi < 2; ++vi) { const int vb = 2 * vh + vi;
                    const bf16x8 af0 = trfrag(VI, tr_rd_perm(F.lane, vb, 2 * sb, 0), tr_rd_perm(F.lane, vb, 2 * sb, 1));
                    const bf16x8 af1 = trfrag(VI, tr_rd_perm(F.lane, vb, 2 * sb + 1, 0), tr_rd_perm(F.lane, vb, 2 * sb + 1, 1));
                    acc[vi] = MFMA32(af0, xf0, acc[vi]); acc[vi] = MFMA32(af1, xf1, acc[vi]); }
            }
        } else {
            const int kt = F.wave - 4;
#pragma unroll
            for (int ks = 0; ks < 4; ++ks) { const bf16x8 af = trfrag(KX, tr_rd(F.lane, kt, ks, 0), tr_rd(F.lane, kt, ks, 1));
#pragma unroll
                for (int vb = 0; vb < 4; ++vb) { const bf16x8 bf = trfrag(VI, tr_rd(F.lane, vb, ks, 0), tr_rd(F.lane, vb, ks, 1)); acc[vb] = MFMA32(af, bf, acc[vb]); } }
        }
        __syncthreads();
        if (F.wave < 4) { const int tb = F.wave & 1, vh = F.wave >> 1;
#pragma unroll
            for (int vi = 0; vi < 2; ++vi)
#pragma unroll
                for (int g = 0; g < 4; ++g) { v2u w; w.x = cvtpk(acc[vi][4 * g], acc[vi][4 * g + 1]); w.y = cvtpk(acc[vi][4 * g + 2], acc[vi][4 * g + 3]);
                    *(LAS v2u*)(OS + (32 * tb + r32) * HG_PITCH + (32 * (2 * vh + vi) + 8 * g + 4 * hi) * 2) = w; }
        } else { const int kt = F.wave - 4;
#pragma unroll
            for (int g = 0; g < 4; ++g) { const f32x4 lm = *(const LAS f32x4*)(lmv + 32 * kt + 8 * g + 4 * hi);
#pragma unroll
                for (int vb = 0; vb < 4; ++vb) { v2u w; w.x = cvtpk(acc[vb][4 * g] * lm.x, acc[vb][4 * g + 1] * lm.y); w.y = cvtpk(acc[vb][4 * g + 2] * lm.z, acc[vb][4 * g + 3] * lm.w);
                    *(LAS v2u*)(UTS + (32 * vb + r32) * HG_PITCH + (32 * kt + 8 * g + 4 * hi) * 2) = w; } }
        }
        __syncthreads();
        { const int row = F.tid >> 3, sg = F.tid & 7;
#pragma unroll
            for (int i = 0; i < 2; ++i) *(GAS v4u*)(F.PROJ + (R0 + row) * NIN + OFF_HF + 128 * h + 16 * sg + 8 * i) = *(const LAS v4u*)(OS + row * HG_PITCH + sg * 32 + i * 16); }
#pragma unroll
        for (int i = 0; i < 4; ++i) { const int n = F.tid + NTHR * i, row = n >> 4, ch = n & 15; *(GAS v4u*)(UST + (size_t)it * 16384 + row * 128 + ch * 8) = *(const LAS v4u*)(UTS + row * HG_PITCH + ch * 16); }
        __syncthreads();
    }
}
__device__ __forceinline__ void phase_hgrn_scan(Frame& F) {
    const float* DV = (const float*)(F.ws + WS_DVEC); const bf16* UST = (const bf16*)(F.ws + WS_UST); bf16* SST = (bf16*)(F.ws + WS_SST);
    for (int e = F.vcu * NTHR + F.tid; e < BATCH * 4 * 2048; e += F.G * NTHR) {
        const int bh = e >> 11, rem = e & 2047, kc = rem & 15;
        float S[8];
#pragma unroll
        for (int i = 0; i < 8; ++i) S[i] = 0.f;
#pragma unroll 4
        for (int c = 0; c < 32; ++c) { const size_t item = (size_t)bh * 32 + c;
            const v4u uu = *(const GAS v4u*)(UST + item * 16384 + rem * 8);
            const f32x4 d0 = *(const GAS f32x4*)(DV + item * 128 + kc * 8), d1 = *(const GAS f32x4*)(DV + item * 128 + kc * 8 + 4);
            v4u so; so.x = pk2(S[0], S[1]); so.y = pk2(S[2], S[3]); so.z = pk2(S[4], S[5]); so.w = pk2(S[6], S[7]);
            *(GAS v4u*)(SST + item * 16384 + rem * 8) = so;
            S[0] = d0.x * S[0] + bflo(uu.x); S[1] = d0.y * S[1] + bfhi(uu.x); S[2] = d0.z * S[2] + bflo(uu.y); S[3] = d0.w * S[3] + bfhi(uu.y);
            S[4] = d1.x * S[4] + bflo(uu.z); S[5] = d1.y * S[5] + bfhi(uu.z); S[6] = d1.z * S[6] + bflo(uu.w); S[7] = d1.w * S[7] + bfhi(uu.w); }
    }
}
__device__ __forceinline__ void phase_hgrn3(Frame& F) {
    LAS unsigned char* QS = F.lds; LAS unsigned char* ST = F.lds + 16384; LAS float* OT = (LAS float*)(F.lds + 49152);
    const bf16* SST = (const bf16*)(F.ws + WS_SST);
    const int r32 = F.lane & 31, hi = F.lane >> 5;
    for (int it = F.vcu; it < BATCH * 4 * 32; it += F.G) {
        const int bh = it >> 5, c = it & 31, b = bh >> 2, h = bh & 3; const size_t R0 = (size_t)b * SEQ + 64 * c;
#pragma unroll
        for (int i = 0; i < 2; ++i) { const int n = F.tid + NTHR * i, row = n >> 4, ch = n & 15; *(LAS v4u*)(QS + off_b(row, ch)) = *(const GAS v4u*)(F.PROJ + (R0 + row) * NIN + OFF_HQ + 128 * h + 8 * ch); }
#pragma unroll
        for (int i = 0; i < 4; ++i) { const int n = F.tid + NTHR * i, row = n >> 4, ch = n & 15; *(LAS v4u*)(ST + off_b(row, ch)) = *(const GAS v4u*)(SST + (size_t)it * 16384 + row * 128 + ch * 8); }
        __syncthreads();
        { const int vb = F.wave & 3, tb = F.wave >> 2; f32x16 acc = f32x16{};
#pragma unroll
            for (int s = 0; s < 8; ++s) { const bf16x8 a = *(const LAS bf16x8*)(ST + row_rd(F.lane, vb, s)), bq = *(const LAS bf16x8*)(QS + row_rd(F.lane, tb, s)); acc = MFMA32(a, bq, acc); }
#pragma unroll
            for (int g = 0; g < 4; ++g) *(LAS f32x4*)(OT + (32 * tb + r32) * 132 + 32 * vb + 8 * g + 4 * hi) = (f32x4){acc[4 * g], acc[4 * g + 1], acc[4 * g + 2], acc[4 * g + 3]}; }
        __syncthreads();
        { const int t = F.tid >> 3, sg = F.tid & 7; float o[16]; float ss = 0.f;
            const bf16* pr = F.PROJ + (R0 + t) * NIN + 128 * h + 16 * sg;
            const v4u i0 = *(const GAS v4u*)(pr + OFF_HF), i1 = *(const GAS v4u*)(pr + OFF_HF + 8), g0 = *(const GAS v4u*)(pr + OFF_HG), g1 = *(const GAS v4u*)(pr + OFF_HG + 8);
            const unsigned iw[8] = {i0.x, i0.y, i0.z, i0.w, i1.x, i1.y, i1.z, i1.w}, gw[8] = {g0.x, g0.y, g0.z, g0.w, g1.x, g1.y, g1.z, g1.w};
#pragma unroll
            for (int j = 0; j < 4; ++j) { const f32x4 x = *(const LAS f32x4*)(OT + t * 132 + 16 * sg + 4 * j); o[4 * j] = x.x; o[4 * j + 1] = x.y; o[4 * j + 2] = x.z; o[4 * j + 3] = x.w; }
#pragma unroll
            for (int j = 0; j < 8; ++j) { o[2 * j] += bflo(iw[j]); o[2 * j + 1] += bfhi(iw[j]); ss += o[2 * j] * o[2 * j] + o[2 * j + 1] * o[2 * j + 1]; }
            ss += __shfl_xor(ss, 1); ss += __shfl_xor(ss, 2); ss += __shfl_xor(ss, 4);
            const float rstd = 1.0f / sqrtf(ss * (1.0f / 128.0f) + EPS);
            unsigned ow[8];
#pragma unroll
            for (int j = 0; j < 8; ++j) { const float w0 = F.gnorm_w[16 * sg + 2 * j], w1 = F.gnorm_w[16 * sg + 2 * j + 1];
                ow[j] = pk2(o[2 * j] * rstd * w0 * siluf_(bflo(gw[j])), o[2 * j + 1] * rstd * w1 * siluf_(bfhi(gw[j]))); }
            bf16* mo = F.MIX + (R0 + t) * DM + 128 * h + 16 * sg;
            *(GAS v4u*)mo = (v4u){ow[0], ow[1], ow[2], ow[3]}; *(GAS v4u*)(mo + 8) = (v4u){ow[4], ow[5], ow[6], ow[7]}; }
        __syncthreads();
    }
}

constexpr float ATT_C2 = 0.125f * 1.4426950408889634f;
constexpr float ATT_THR = 0.0f;
__device__ __forceinline__ void attn_unit(Frame& F, int b, int h, int qb, float lam) {
    LAS unsigned char* KB = F.lds; LAS unsigned char* VB = F.lds + 32768; LAS float* CMB = (LAS float*)(F.lds + 65536);
    const int mp = F.wave >> 2, qg = F.wave & 3, r32 = F.lane & 31, hi = F.lane >> 5;
    const size_t rowbase = (size_t)b * SEQ; const int q0 = 128 * qb, NT = 2 * qb + 2, qpos = q0 + 32 * qg + r32;
    const float sl2 = exp2f(-2.0f * (h + 1)) * 1.4426950408889634f;
    bf16x8 qr[4];
#pragma unroll
    for (int d0 = 0; d0 < 4; ++d0) { const v4u raw = *(const GAS v4u*)(F.PROJ + (rowbase + qpos) * NIN + OFF_AQ + 128 * h + 64 * mp + 16 * d0 + 8 * hi);
        v4u w; w.x = pk2(bflo(raw.x) * ATT_C2, bfhi(raw.x) * ATT_C2); w.y = pk2(bflo(raw.y) * ATT_C2, bfhi(raw.y) * ATT_C2); w.z = pk2(bflo(raw.z) * ATT_C2, bfhi(raw.z) * ATT_C2); w.w = pk2(bflo(raw.w) * ATT_C2, bfhi(raw.w) * ATT_C2);
        qr[d0] = __builtin_bit_cast(bf16x8, w); }
    unsigned ka[4], va[2][4];
    { const unsigned xr = ((r32 & 3) << 2) | ((r32 >> 2) & 3);
#pragma unroll
        for (int d0 = 0; d0 < 4; ++d0) ka[d0] = 256u * r32 + 16u * (hi ^ (xr & 1)) + 32u * ((unsigned)(4 * mp + d0) ^ (xr >> 1));
        const unsigned blk = (F.lane >> 4) & 1, q4 = (F.lane & 15) >> 2, p4 = F.lane & 3;
#pragma unroll
        for (int t = 0; t < 2; ++t)
#pragma unroll
            for (int c = 0; c < 4; ++c) va[t][c] = 2048u * t + 1024u * hi + 256u * q4 + 16u * ((2 * blk + (p4 >> 1)) ^ (unsigned)(2 * t + hi)) + 8u * (p4 & 1) + 64u * ((unsigned)c ^ q4); }
    float m = 0.f, l = 0.f; f32x16 o[4];
#pragma unroll
    for (int i = 0; i < 4; ++i) o[i] = f32x16{};
    const bf16* kg = F.PROJ + rowbase * NIN + OFF_AK + 128 * h; const bf16* vg = F.PROJ + rowbase * NIN + OFF_AV + 128 * h;
    v4u kk[2], vv[2];
#define ATT_LOAD(j) do { _Pragma("unroll") for (int i_ = 0; i_ < 2; ++i_) { const int n_ = F.tid + NTHR * i_, row_ = n_ >> 4, ch_ = n_ & 15; \
        kk[i_] = *(const GAS v4u*)(kg + (size_t)(64 * (j) + row_) * NIN + 8 * ch_); vv[i_] = *(const GAS v4u*)(vg + (size_t)(64 * (j) + row_) * NIN + 8 * ch_); } } while (0)
#define ATT_WRITE(buf) do { _Pragma("unroll") for (int i_ = 0; i_ < 2; ++i_) { const int n_ = F.tid + NTHR * i_, row_ = n_ >> 4, ch_ = n_ & 15; \
        *(LAS v4u*)(KB + (buf) * 16384 + off_b(row_, ch_)) = kk[i_]; *(LAS v4u*)(VB + (buf) * 16384 + off_b(row_, ch_)) = vv[i_]; } } while (0)
    ATT_LOAD(0); ATT_WRITE(0);
    __syncthreads();
    for (int j = 0; j < NT; ++j) {
        if (j + 1 < NT) ATT_LOAD(j + 1);
        const bool active = !(j == NT - 1 && qg < 2);
        if (active) {
            LAS unsigned char* Kt = KB + (j & 1) * 16384; LAS unsigned char* Vt = VB + (j & 1) * 16384;
            const float tb0 = sl2 * (float)(64 * j + 4 * hi - qpos) - m, tb1 = tb0 + 32.0f * sl2;
            f32x16 p0, p1;
#pragma unroll
            for (int r = 0; r < 16; ++r) { const float cr = (float)((r & 3) + 8 * (r >> 2)); p0[r] = fmaf(cr, sl2, tb0); p1[r] = fmaf(cr, sl2, tb1); }
#pragma unroll
            for (int d0 = 0; d0 < 4; ++d0) { const bf16x8 a0 = *(const LAS bf16x8*)(Kt + ka[d0]), a1 = *(const LAS bf16x8*)(Kt + ka[d0] + 8192);
                p0 = MFMA32(a0, qr[d0], p0); p1 = MFMA32(a1, qr[d0], p1); }
            if (j >= NT - 2) { const int kv0 = 64 * j + 4 * hi;
#pragma unroll
                for (int r = 0; r < 16; ++r) { const int kv = kv0 + (r & 3) + 8 * (r >> 2); if (kv > qpos) p0[r] = -INFINITY; if (kv + 32 > qpos) p1[r] = -INFINITY; } }
            float rm = fmaxf(p0[0], p1[0]);
#pragma unroll
            for (int r = 1; r < 16; ++r) rm = fmaxf(rm, fmaxf(p0[r], p1[r]));
            rm = fmaxf(rm, __shfl_xor(rm, 32));
            if (j == 0 || __any(rm > ATT_THR)) {
                const float dl = (j == 0) ? rm : fmaxf(rm, 0.f); m += dl;
#pragma unroll
                for (int r = 0; r < 16; ++r) { p0[r] -= dl; p1[r] -= dl; }
                if (j > 0) { const float f = exp2f(-dl); l *= f;
#pragma unroll
                    for (int i = 0; i < 4; ++i) o[i] *= f; }
            }
            float ps = 0.f;
#pragma unroll
            for (int r = 0; r < 16; ++r) { p0[r] = exp2f(p0[r]); p1[r] = exp2f(p1[r]); ps += p0[r] + p1[r]; }
            l += ps;
            bf16x8 pf[4]; pf[0] = pack8(p0, 0); pf[1] = pack8(p0, 8); pf[2] = pack8(p1, 0); pf[3] = pack8(p1, 8);
#pragma unroll
            for (int ks = 0; ks < 4; ++ks)
#pragma unroll
                for (int c = 0; c < 4; ++c) { const bf16x8 af = trfrag(Vt + 4096 * ks, va[0][c], va[1][c]); o[c] = MFMA32(af, pf[ks], o[c]); }
        }
        if (j + 1 < NT) ATT_WRITE((j + 1) & 1);
        __syncthreads();
    }
#undef ATT_LOAD
#undef ATT_WRITE
    l += __shfl_xor(l, 32);
    const float inv = 1.0f / l;
    if (mp == 1) { const float sc = lam * inv;
#pragma unroll
        for (int c = 0; c < 4; ++c)
#pragma unroll
            for (int r = 0; r < 16; ++r) CMB[qg * 4096 + (c * 16 + r) * 64 + F.lane] = o[c][r] * sc; }
    __syncthreads();
    if (mp == 0) { float ss = 0.f;
#pragma unroll
        for (int c = 0; c < 4; ++c)
#pragma unroll
            for (int r = 0; r < 16; ++r) { const float v = o[c][r] * inv - CMB[qg * 4096 + (c * 16 + r) * 64 + F.lane]; o[c][r] = v; ss += v * v; }
        ss += __shfl_xor(ss, 32);
        const float rstd = (1.0f - LAMBDA_INIT) / sqrtf(ss * (1.0f / 128.0f) + EPS);
        bf16* mo = F.MIX + (rowbase + qpos) * DM + 512 + 128 * h;
#pragma unroll
        for (int c = 0; c < 4; ++c)
#pragma unroll
            for (int g = 0; g < 4; ++g) { const int d = 32 * c + 8 * g + 4 * hi; const f32x4 w = *(const GAS f32x4*)(F.subln_w + d);
                v2u ow; ow.x = pk2(o[c][4 * g] * rstd * w.x, o[c][4 * g + 1] * rstd * w.y); ow.y = pk2(o[c][4 * g + 2] * rstd * w.z, o[c][4 * g + 3] * rstd * w.w);
                *(GAS v2u*)(mo + d) = ow; }
    }
    __syncthreads();
}
__device__ __forceinline__ void phase_attn(Frame& F) {
    const float lam = diff_lambda(F);
    for (int slot = F.vcu; slot < 256; slot += F.G) {
        const int bh = slot >> 2, s0 = 2 * (slot & 3);
        for (int u = 0; u < 4; ++u) { const int qb = (u == 0) ? s0 : (u == 1) ? 15 - s0 : (u == 2) ? s0 + 1 : 14 - s0; attn_unit(F, bh >> 2, bh & 3, qb, lam); }
    }
}
struct EpiGateS { bf16* O; __device__ __forceinline__ void operator()(int r, int c, float v) const { O[(size_t)r * DFF + c] = (bf16)f2bf(v); } };

enum { PH_PRO = 0, PH_NORM1, PH_INPROJ, PH_MIX1, PH_MIX2, PH_MIXER, PH_OUTPROJ, PH_NORM2, PH_FFN1, PH_FFN2, PH_FINAL, PH_COUNT };
struct Args { const float* in[19]; float* out; unsigned char* ws; int ph_lo, ph_hi; };

__global__ void __launch_bounds__(NTHR, 2) fwd(Args args) {
    extern __shared__ __attribute__((aligned(16))) unsigned char lds[];
    Frame F;
    F.lds = (LAS unsigned char*)lds;
    F.tid = threadIdx.x; F.lane = F.tid & 63; F.wave = __builtin_amdgcn_readfirstlane(F.tid >> 6);
    F.G = gridDim.x; { const int bx = blockIdx.x; F.vcu = (F.G % 8 == 0) ? (bx % 8) * (F.G / 8) + bx / 8 : bx; }
    F.x = args.in[0]; F.c = args.in[1]; F.w_ada = args.in[2]; F.b_ada = args.in[3]; F.norm1_w = args.in[4]; F.w_in = args.in[5]; F.lb_logits = args.in[6]; F.gnorm_w = args.in[7];
    F.lq1 = args.in[8]; F.lk1 = args.in[9]; F.lq2 = args.in[10]; F.lk2 = args.in[11]; F.subln_w = args.in[12]; F.w_out = args.in[13]; F.norm2_w = args.in[14];
    F.w_gate = args.in[15]; F.w_up = args.in[16]; F.w_down = args.in[17]; F.final_w = args.in[18];
    F.out = args.out; F.ws = args.ws;
    F.MOD = (float*)(args.ws + WS_MOD); F.WIN = (bf16*)(args.ws + WS_WIN); F.WOUT = (bf16*)(args.ws + WS_WOUT); F.WGU = (bf16*)(args.ws + WS_WGU); F.WDN = (bf16*)(args.ws + WS_WDN);
    F.U = (bf16*)(args.ws + WS_U); F.MIX = (bf16*)(args.ws + WS_MIX); F.PROJ = (bf16*)(args.ws + WS_PROJ); F.ACT = (bf16*)(args.ws + WS_PROJ);
    for (int u = F.tid; u < (LDS_BYTES - LDSCTL_OFF) / 4; u += NTHR) ((LAS unsigned*)(F.lds + LDSCTL_OFF))[u] = 0u;
    __syncthreads();
    unsigned* ctl = (unsigned*)(args.ws + WS_CTL);
    XcdBarrier bar; bar.bar = ctl + CW_BAR; bar.x = 0; bar.st = nullptr;
    if (MK_N_LAUNCHES == 1) bar = xcd_barrier_post(ctl + CW_BAR, (volatile LAS unsigned*)(F.lds + MISC_OFF) + 8);
    const int lo = args.ph_lo, hi = args.ph_hi;
#define IN(k) (lo <= (k) && (k) < hi)
#define SEAM(k) do { if (IN(k) && IN((k) + 1)) xcd_barrier(bar); } while (0)

    if (IN(PH_PRO)) { phase_wconv(F); __syncthreads(); phase_mod(F); }
    SEAM(PH_PRO);
    if (IN(PH_NORM1)) phase_modnorm(F, F.x, F.norm1_w, 0, DM);
    SEAM(PH_NORM1);
    if (IN(PH_INPROJ)) {
#if FAST_GEMM
        pg8::Gemm g{F.U, F.WIN, M, NIN, DM}; pg8::StaticOrder S; S.init(M, NIN, F.G, (int)blockIdx.x);
        pg8::EpiBf16<0> E{F.PROJ, NIN, nullptr, 0, 0, 1.f};
        pg8::gemm_phase<pg8::EpiBf16<0>, pg8::StaticOrder, PG8_ALIGN, PG8_SP2>(F.lds, g, S, E);
#else
        EpiProjS E{F.PROJ}; gemm_simple(F, F.U, F.WIN, M, NIN, DM, E);
#endif
    }
    SEAM(PH_INPROJ);
#if PROBE
    if (IN(PH_MIX1)) {
        bf16* CMP = (bf16*)(F.ws + WS_U);
        phase_hgrn_naive(F, CMP); phase_attn_naive(F, CMP);
        xcd_barrier(bar);
        phase_hgrn1(F); xcd_barrier(bar); phase_hgrn_scan(F); xcd_barrier(bar); phase_hgrn3(F);
#if FAST_ATTN
        phase_attn(F);
#endif
        xcd_barrier(bar);
        float md = 0.f;
        for (size_t e = (size_t)F.vcu * NTHR + F.tid; e < (size_t)M * 128; e += (size_t)F.G * NTHR) {
            const size_t row = e >> 7; const int cc = (int)(e & 127) * 8;
            if (cc < PROBE_LO || cc >= PROBE_HI || (int)(row % SEQ) < PROBE_TMIN) continue;
            const v4u a = *(const GAS v4u*)(F.MIX + row * DM + cc), b = *(const GAS v4u*)(CMP + row * DM + cc);
            md = fmaxf(md, fmaxf(fabsf(bflo(a.x) - bflo(b.x)), fabsf(bfhi(a.x) - bfhi(b.x)))); md = fmaxf(md, fmaxf(fabsf(bflo(a.y) - bflo(b.y)), fabsf(bfhi(a.y) - bfhi(b.y))));
            md = fmaxf(md, fmaxf(fabsf(bflo(a.z) - bflo(b.z)), fabsf(bfhi(a.z) - bfhi(b.z)))); md = fmaxf(md, fmaxf(fabsf(bflo(a.w) - bflo(b.w)), fabsf(bfhi(a.w) - bfhi(b.w))));
        }
        md = wave_max(md);
        if (F.lane == 0) atomicMax(ctl + CW_DIAG, __float_as_uint(md));
        xcd_barrier(bar);
        for (size_t e = (size_t)F.vcu * NTHR + F.tid; e < (size_t)M * 128; e += (size_t)F.G * NTHR) *(GAS v4u*)(F.MIX + e * 8) = *(const GAS v4u*)(CMP + e * 8);
    }
    SEAM(PH_MIX1);
#else
#if FAST_HGRN
    if (IN(PH_MIX1)) phase_hgrn1(F);
    SEAM(PH_MIX1);
    if (IN(PH_MIX2)) phase_hgrn_scan(F);
    SEAM(PH_MIX2);
    if (IN(PH_MIXER)) { phase_hgrn3(F);
#else
    if (IN(PH_MIXER)) { phase_hgrn_naive(F, F.MIX);
#endif
#if FAST_ATTN
        phase_attn(F);
#else
        phase_attn_naive(F, F.MIX);
#endif
    }
#endif
    SEAM(PH_MIXER);
    if (IN(PH_OUTPROJ)) {
#if FAST_GEMM
        pg8::Gemm g{F.MIX, F.WOUT, M, DM, DM}; pg8::StaticOrder S; S.init(M, DM, F.G, (int)blockIdx.x);
        pg8::EpiResGate E{F.x, F.out, F.MOD + 2 * DM, DM, SEQ, NMOD};
        pg8::gemm_phase<pg8::EpiResGate, pg8::StaticOrder, PG8_ALIGN, PG8_SP2>(F.lds, g, S, E);
#else
        EpiResS E{F.x, F.MOD + 2 * DM, F.out}; gemm_simple(F, F.MIX, F.WOUT, M, DM, DM, E);
#endif
    }
    SEAM(PH_OUTPROJ);
    if (IN(PH_NORM2)) phase_modnorm(F, F.out, F.norm2_w, 3 * DM, 4 * DM);
    SEAM(PH_NORM2);
    if (IN(PH_FFN1)) {
#if FAST_GEMM
        pg8::Gemm g{F.U, F.WGU, M, 2 * DFF, DM}; pg8::StaticOrder S; S.init(M, 2 * DFF, F.G, (int)blockIdx.x);
        pg8::EpiSwiGLU E{F.ACT, DFF};
        pg8::gemm_phase<pg8::EpiSwiGLU, pg8::StaticOrder, PG8_ALIGN, PG8_SP2>(F.lds, g, S, E);
#else
        const int gw = F.vcu * NWAVES + F.wave, NGW = F.G * NWAVES; const int r16 = F.lane & 15, q = F.lane >> 4;
        const int ntn = DFF / 64, ntiles = (M / 64) * ntn;
        for (int t = gw; t < ntiles; t += NGW) {
            const int tm = t / ntn, tn = t % ntn;
            const int grow = ((tn * 64) / 128) * 256 + ((tn * 64) % 128);
            f32x4 ag[4][4], au[4][4];
#pragma unroll
            for (int i = 0; i < 4; ++i)
#pragma unroll
                for (int j = 0; j < 4; ++j) { ag[i][j] = (f32x4){0.f, 0.f, 0.f, 0.f}; au[i][j] = (f32x4){0.f, 0.f, 0.f, 0.f}; }
            const bf16* ap = F.U + (size_t)(tm * 64 + r16) * DM + q * 8;
            const bf16* gp = F.WGU + (size_t)(grow + r16) * DM + q * 8;
            for (int k0 = 0; k0 < DM; k0 += 32) {
                bf16x8 a[4], g[4], u[4];
#pragma unroll
                for (int i = 0; i < 4; ++i) { a[i] = *(const GAS bf16x8*)(ap + (size_t)i * 16 * DM + k0); g[i] = *(const GAS bf16x8*)(gp + (size_t)i * 16 * DM + k0); u[i] = *(const GAS bf16x8*)(gp + (size_t)(128 + i * 16) * DM + k0); }
#pragma unroll
                for (int i = 0; i < 4; ++i)
#pragma unroll
                    for (int j = 0; j < 4; ++j) { ag[i][j] = __builtin_amdgcn_mfma_f32_16x16x32_bf16(a[i], g[j], ag[i][j], 0, 0, 0); au[i][j] = __builtin_amdgcn_mfma_f32_16x16x32_bf16(a[i], u[j], au[i][j], 0, 0, 0); }
            }
#pragma unroll
            for (int i = 0; i < 4; ++i)
#pragma unroll
                for (int j = 0; j < 4; ++j)
#pragma unroll
                    for (int e = 0; e < 4; ++e) { const int r = tm * 64 + i * 16 + q * 4 + e, c = tn * 64 + j * 16 + r16;
                        F.ACT[(size_t)r * DFF + c] = (bf16)f2bf(siluf_(ag[i][j][e]) * au[i][j][e]); }
        }
#endif
    }
    SEAM(PH_FFN1);
    if (IN(PH_FFN2)) {
#if FAST_GEMM
        pg8::Gemm g{F.ACT, F.WDN, M, DM, DFF}; pg8::StaticOrder S; S.init(M, DM, F.G, (int)blockIdx.x);
        pg8::EpiResGate E{F.out, F.out, F.MOD + 5 * DM, DM, SEQ, NMOD};
        pg8::gemm_phase<pg8::EpiResGate, pg8::StaticOrder, PG8_ALIGN, PG8_SP2>(F.lds, g, S, E);
#else
        EpiResS E{F.out, F.MOD + 5 * DM, F.out}; gemm_simple(F, F.ACT, F.WDN, M, DM, DFF, E);
#endif
    }
    SEAM(PH_FFN2);
#if PROBE
    if (IN(PH_FINAL)) { const float dd = __uint_as_float(__hip_atomic_load(ctl + CW_DIAG, __ATOMIC_RELAXED, __HIP_MEMORY_SCOPE_AGENT)); phase_final_norm(F, 1.0f + exp2f(ceilf(log2f(fmaxf(dd, 1e-6f))))); }
#else
    if (IN(PH_FINAL)) phase_final_norm(F, 1.0f);
#endif
#undef IN
#undef SEAM
}

extern "C" void kernel_launch(void* const* d_in, const int* in_sizes, int n_in, void* d_out, int out_size, void* d_ws, size_t ws_size, hipStream_t stream) {
    static int grid = 0;
    if (grid == 0) {
        if (n_in != 19 || in_sizes[0] != M * DM || out_size != M * DM || ws_size < WS_END) { fprintf(stderr, "kernel_launch: unexpected shapes (n_in %d in0 %d out %d ws %zu)\n", n_in, n_in > 0 ? in_sizes[0] : -1, out_size, ws_size); grid = -1; return; }
        int dev = 0, cus = 0;
        if (hipGetDevice(&dev) != hipSuccess || hipDeviceGetAttribute(&cus, hipDeviceAttributeMultiprocessorCount, dev) != hipSuccess) { grid = -1; return; }
        if (hipFuncSetAttribute((const void*)fwd, hipFuncAttributeMaxDynamicSharedMemorySize, LDS_BYTES) != hipSuccess) { fprintf(stderr, "kernel_launch: hipFuncSetAttribute failed\n"); grid = -1; return; }
        int per_cu = 0;
        if (hipOccupancyMaxActiveBlocksPerMultiprocessor(&per_cu, (const void*)fwd, NTHR, LDS_BYTES) != hipSuccess || per_cu < 1) fprintf(stderr, "kernel_launch: occupancy query reports %d\n", per_cu);
        (void)hipGetLastError();
        grid = cus;
    }
    if (grid < 0) return;
    (void)hipMemsetAsync((char*)d_ws + WS_CTL, 0, CTL_ZERO_BYTES, stream);
    Args a{};
    for (int i = 0; i < 19; ++i) a.in[i] = (const float*)d_in[i];
    a.out = (float*)d_out; a.ws = (unsigned char*)d_ws;
    if (MK_N_LAUNCHES == 1) { a.ph_lo = 0; a.ph_hi = PH_COUNT; hipLaunchKernelGGL(fwd, dim3(grid), dim3(NTHR), LDS_BYTES, stream, a); }
    else for (int p = 0; p < PH_COUNT; ++p) { a.ph_lo = p; a.ph_hi = p + 1; hipLaunchKernelGGL(fwd, dim3(grid), dim3(NTHR), LDS_BYTES, stream, a); }
}
```
